# Optimizing an MI355X kernel written in HIP

```python
import math
import jax, jax.numpy as jnp
from jax import lax
import numpy as np

D_MODEL = 1024
BATCH = 1
SEQ = 16384
DEPTH = 2
DEC_BATCH = 16
DEC_SEQ = 4096
PAST_LEN = 128

GRID_W = 64
HEAD_DIM = 64
NA_HEADS = 8
DIFF_HEADS = 4
NA_WIDTH = NA_HEADS * HEAD_DIM
DIFF_QK_WIDTH = DIFF_HEADS * 2 * HEAD_DIM
DIFF_V_DIM = 2 * HEAD_DIM
DIFF_V_WIDTH = DIFF_HEADS * DIFF_V_DIM
IN_WIDTH = 3 * NA_WIDTH + 2 * DIFF_QK_WIDTH + DIFF_V_WIDTH + 2 * D_MODEL
D_FF = 256 * ((8 * D_MODEL // 3 + 255) // 256)
WIN_H = 8
WIN_W = 16
COL_QBLOCK = 16
COL_KBLOCK = 32
ROPE_THETA = 500000.0
ROPE_DIM = HEAD_DIM // 4
Q_BLOCK = 128
NORM_EPS = 1e-6
SUBLN_EPS = 1e-5
NEG_INF = -1e30
FFN_RES = 0.5

kernel_name = "hybrid_natten_diffattn_macaron_encoder"

F32 = jnp.float32


def rms_norm(x, g, eps=NORM_EPS):
    xf = x.astype(F32)
    y = xf * lax.rsqrt(jnp.mean(xf * xf, axis=-1, keepdims=True) + eps)
    return (y * g.astype(F32)).astype(x.dtype)


def swiglu_ffn(x, wi, wo):
    a, b = jnp.split(x @ wi, 2, axis=-1)
    return (jax.nn.silu(a) * b) @ wo


def partial_rope(x, positions):
    half = ROPE_DIM // 2
    inv_freq = jnp.power(ROPE_THETA, -jnp.arange(half, dtype=F32) * 2.0 / ROPE_DIM)
    ang = positions[:, None] * inv_freq[None, :]
    cos = jnp.cos(ang)[None, :, None, None, :].astype(x.dtype)
    sin = jnp.sin(ang)[None, :, None, None, :].astype(x.dtype)
    x1 = x[..., :half]
    x2 = x[..., half:ROPE_DIM]
    rest = x[..., ROPE_DIM:]
    return jnp.concatenate([x1 * cos - x2 * sin, x2 * cos + x1 * sin, rest], axis=-1)


def neighbourhood_attention(q, k, v, rpb):
    B, L, H, DH = q.shape
    rows = L // GRID_W
    kh = min(WIN_H, rows)
    n_cb = GRID_W // COL_QBLOCK
    qcol = np.arange(GRID_W).reshape(n_cb, COL_QBLOCK)
    kc0 = np.clip(np.arange(n_cb) * COL_QBLOCK - WIN_W // 2, 0, GRID_W - COL_KBLOCK)
    kcol = kc0[:, None] + np.arange(COL_KBLOCK)
    wstart = np.clip(qcol - WIN_W // 2, 0, GRID_W - WIN_W)
    col_mask = (kcol[:, None, :] >= wstart[:, :, None]) & (kcol[:, None, :] < wstart[:, :, None] + WIN_W)
    dc = np.clip(kcol[:, None, :] - qcol[:, :, None] + WIN_W - 1, 0, 2 * WIN_W - 2)
    bias_c = jnp.where(col_mask, rpb[:, :, dc].astype(F32), NEG_INF)
    scale = DH ** -0.5
    q_rows = q.reshape(B, rows, n_cb, COL_QBLOCK, H, DH).transpose(1, 0, 2, 3, 4, 5)
    kg = k.reshape(B, rows, GRID_W, H, DH)
    vg = v.reshape(B, rows, GRID_W, H, DH)

    def row_block(args):
        r, q_row = args
        s0 = jnp.clip(r - kh // 2, 0, rows - kh)
        k_rows = lax.dynamic_slice_in_dim(kg, s0, kh, axis=1)
        v_rows = lax.dynamic_slice_in_dim(vg, s0, kh, axis=1)
        k_blk = k_rows[:, :, kcol]
        v_blk = v_rows[:, :, kcol]
        dr = s0 + jnp.arange(kh) - r + WIN_H - 1
        bias = bias_c[:, dr].transpose(0, 2, 3, 1, 4)
        s = jnp.einsum('bjqhd,bijkhd->bhjqik', q_row, k_blk).astype(F32) * scale + bias
        p = jax.nn.softmax(s.reshape(s.shape[:4] + (kh * COL_KBLOCK,)), axis=-1).reshape(s.shape)
        o = jnp.einsum('bhjqik,bijkhd->bjqhd', p.astype(v.dtype), v_blk)
        return o.reshape(B, GRID_W, H, DH)

    out = lax.map(row_block, (jnp.arange(rows), q_rows))
    return out.transpose(1, 0, 2, 3, 4).reshape(B, L, H * DH)


def differential_attention(q, k, v, lam, lam_init, subln_g):
    B, L, H, _, DH = q.shape
    nb = L // Q_BLOCK
    scale = DH ** -0.5
    q_blocks = q.reshape(B, nb, Q_BLOCK, H, 2, DH).transpose(1, 0, 2, 3, 4, 5)

    def q_block(q_blk):
        s = jnp.einsum('bqhmd,bkhmd->bhmqk', q_blk, k).astype(F32) * scale
        p = jax.nn.softmax(s, axis=-1)
        a = p[:, :, 0] - lam * p[:, :, 1]
        return jnp.einsum('bhqk,bkhe->bqhe', a.astype(v.dtype), v)

    o = lax.map(q_block, q_blocks)
    o = o.transpose(1, 0, 2, 3, 4).reshape(B, L, H, 2 * DH)
    o = rms_norm(o, subln_g, SUBLN_EPS) * (1.0 - lam_init)
    return o.reshape(B, L, H * 2 * DH)


def encoder_layer(x, layer_idx, ffn1_norm, ffn1_wi, ffn1_wo, mix_norm, w_in, qa_norm, ka_norm, rpb,
                  qb_norm, kb_norm, lam_q1, lam_k1, lam_q2, lam_k2, subln, w_a_out, w_b_out, w_o,
                  ffn2_norm, ffn2_wi, ffn2_wo):
    B, L, _ = x.shape
    x = x + FFN_RES * swiglu_ffn(rms_norm(x, ffn1_norm), ffn1_wi, ffn1_wo)
    u = rms_norm(x, mix_norm)
    proj = u @ w_in
    splits = np.cumsum([NA_WIDTH] * 3 + [DIFF_QK_WIDTH] * 2 + [DIFF_V_WIDTH, D_MODEL]).tolist()
    qa, ka, va, qb, kb, vb, ga, gb = jnp.split(proj, splits, axis=-1)
    qa = rms_norm(qa.reshape(B, L, NA_HEADS, HEAD_DIM), qa_norm)
    ka = rms_norm(ka.reshape(B, L, NA_HEADS, HEAD_DIM), ka_norm)
    va = va.reshape(B, L, NA_HEADS, HEAD_DIM)
    ya = neighbourhood_attention(qa, ka, va, rpb) @ w_a_out
    pos = jnp.arange(L, dtype=F32)
    qb = partial_rope(rms_norm(qb.reshape(B, L, DIFF_HEADS, 2, HEAD_DIM), qb_norm), pos)
    kb = partial_rope(rms_norm(kb.reshape(B, L, DIFF_HEADS, 2, HEAD_DIM), kb_norm), pos)
    vb = vb.reshape(B, L, DIFF_HEADS, DIFF_V_DIM)
    lam_init = 0.8 - 0.6 * math.exp(-0.3 * layer_idx)
    lam = (jnp.exp(jnp.sum(lam_q1.astype(F32) * lam_k1.astype(F32)))
           - jnp.exp(jnp.sum(lam_q2.astype(F32) * lam_k2.astype(F32))) + lam_init)
    yb = differential_attention(qb, kb, vb, lam, lam_init, subln) @ w_b_out
    merged = jax.nn.sigmoid(ga) * ya + jax.nn.sigmoid(gb) * yb
    x = x + merged @ w_o
    x = x + FFN_RES * swiglu_ffn(rms_norm(x, ffn2_norm), ffn2_wi, ffn2_wo)
    return x


def setup_inputs(seed: int = 0) -> dict:
    key = jax.random.key(seed)
    ks = jax.random.split(key, 24)

    def nrm(k, shape, scale):
        return jax.random.normal(k, shape, F32) * scale

    def gain(k, shape):
        return 1.0 + 0.05 * jax.random.normal(k, shape, F32)

    return {
        "x_prompt": nrm(ks[0], (BATCH, SEQ, D_MODEL), 1.0),
        "x_sample": nrm(ks[1], (DEC_BATCH, DEC_SEQ, D_MODEL), 1.0),
        "ffn1_norm": gain(ks[2], (DEPTH, D_MODEL)),
        "ffn1_wi": nrm(ks[3], (DEPTH, D_MODEL, 2 * D_FF), D_MODEL ** -0.5),
        "ffn1_wo": nrm(ks[4], (DEPTH, D_FF, D_MODEL), D_FF ** -0.5),
        "mix_norm": gain(ks[5], (DEPTH, D_MODEL)),
        "w_in": nrm(ks[6], (DEPTH, D_MODEL, IN_WIDTH), D_MODEL ** -0.5),
        "qa_norm": gain(ks[7], (DEPTH, HEAD_DIM)),
        "ka_norm": gain(ks[8], (DEPTH, HEAD_DIM)),
        "rpb": nrm(ks[9], (DEPTH, NA_HEADS, 2 * WIN_H - 1, 2 * WIN_W - 1), 0.1),
        "qb_norm": gain(ks[10], (DEPTH, HEAD_DIM)),
        "kb_norm": gain(ks[11], (DEPTH, HEAD_DIM)),
        "lam_q1": nrm(ks[12], (DEPTH, HEAD_DIM), 0.1),
        "lam_k1": nrm(ks[13], (DEPTH, HEAD_DIM), 0.1),
        "lam_q2": nrm(ks[14], (DEPTH, HEAD_DIM), 0.1),
        "lam_k2": nrm(ks[15], (DEPTH, HEAD_DIM), 0.1),
        "subln": gain(ks[16], (DEPTH, DIFF_V_DIM)),
        "w_a_out": nrm(ks[17], (DEPTH, NA_WIDTH, D_MODEL), NA_WIDTH ** -0.5),
        "w_b_out": nrm(ks[18], (DEPTH, DIFF_V_WIDTH, D_MODEL), DIFF_V_WIDTH ** -0.5),
        "w_o": nrm(ks[19], (DEPTH, D_MODEL, D_MODEL), D_MODEL ** -0.5),
        "ffn2_norm": gain(ks[20], (DEPTH, D_MODEL)),
        "ffn2_wi": nrm(ks[21], (DEPTH, D_MODEL, 2 * D_FF), D_MODEL ** -0.5),
        "ffn2_wo": nrm(ks[22], (DEPTH, D_FF, D_MODEL), D_FF ** -0.5),
    }


def reference(x_prompt, x_sample, ffn1_norm, ffn1_wi, ffn1_wo, mix_norm, w_in, qa_norm, ka_norm, rpb,
              qb_norm, kb_norm, lam_q1, lam_k1, lam_q2, lam_k2, subln, w_a_out, w_b_out, w_o,
              ffn2_norm, ffn2_wi, ffn2_wo):
    y_prompt = x_prompt
    y_sample = x_sample
    for l in range(DEPTH):
        layer_args = (ffn1_norm[l], ffn1_wi[l], ffn1_wo[l], mix_norm[l], w_in[l], qa_norm[l], ka_norm[l],
                      rpb[l], qb_norm[l], kb_norm[l], lam_q1[l], lam_k1[l], lam_q2[l], lam_k2[l], subln[l],
                      w_a_out[l], w_b_out[l], w_o[l], ffn2_norm[l], ffn2_wi[l], ffn2_wo[l])
        y_prompt = encoder_layer(y_prompt, l, *layer_args)
        y_sample = encoder_layer(y_sample, l, *layer_args)
    return (y_prompt, y_sample)
```

```cpp
#include <hip/hip_runtime.h>
#include <hip/hip_cooperative_groups.h>
#include <cstdio>
#include <cstdint>
namespace cg = cooperative_groups;
namespace pg8 {
#define PG8_LAS __attribute__((address_space(3)))
typedef unsigned short bf16_t;
typedef short bf16x8 __attribute__((ext_vector_type(8)));
typedef float f32x4 __attribute__((ext_vector_type(4)));
typedef unsigned u32x4 __attribute__((ext_vector_type(4)));
constexpr int BM = 256, BK = 64, HALF = 128, HTB = HALF * BK * 2  , STAGE_BYTES = 8 * HTB, NXCD = 8, WGM = 8;

__host__ __device__ __forceinline__ int lds_byte(int r, int c) { const int st = (r >> 4) * 2 + (c >> 5), rr = r & 15, cc = c & 31, ob = rr * 64 + cc * 2; return st * 1024 + (ob ^ (((ob >> 9) & 1) << 5)); }
__host__ __device__ __forceinline__ void stage_rc(int b, int& R, int& C) { const int st = b / 1024, sb = b % 1024, swz = sb ^ (((sb >> 9) & 1) << 5); R = (st >> 1) * 16 + swz / 64; C = (st & 1) * 32 + (swz % 64) / 2; }
__host__ __device__ __forceinline__ int perm32(int rho) { const int n = rho >> 4, i = rho & 15; return 8 * (i >> 2) + 4 * n + (i & 3); }

struct Unit { int pm, pn; };
struct Gemm { const bf16_t* A; const bf16_t* Bt; int M, N, K; int lda = 0, aselb = 0; };

struct StaticOrder {
    int nM, nN, nwg, G, c, nr, rev;
    __host__ __device__ void init(int M, int N, int G_, int c_, int rev_ = 0) { nM = M / BM; nN = N / BM; nwg = nM * nN; G = G_; c = c_; rev = rev_; nr = (c < nwg) ? (nwg - c + G - 1) / G : 0; }
    __host__ __device__ bool next(int i, Unit& u) const {
        if (i >= nr) return false;
        const long L = (long)(rev ? nr - 1 - i : i) * G + c;
        int wgid = (int)L; { const int q = nwg / NXCD, r = nwg % NXCD, xcd = wgid % NXCD, off = wgid / NXCD; wgid = (xcd < r ? xcd * (q + 1) : r * (q + 1) + (xcd - r) * q) + off; }
        const int nig = WGM * nN, gid = wgid / nig, fm = gid * WGM, gsz = (nM - fm) < WGM ? (nM - fm) : WGM;
        u.pm = fm + ((wgid % nig) % gsz); u.pn = (wgid % nig) / gsz; return true;
    }
    __device__ __forceinline__ void a_ready(const Unit&) const {}
    __device__ __forceinline__ void done(const Unit&) const {}
};

typedef float f32x2c_ __attribute__((ext_vector_type(2))); typedef __bf16 bf16x2c_ __attribute__((ext_vector_type(2)));
__device__ __forceinline__ unsigned cvt_pk_bf16(float lo, float hi) { f32x2c_ v = {lo, hi}; bf16x2c_ b = __builtin_convertvector(v, bf16x2c_); return __builtin_bit_cast(unsigned, b); }
typedef float f32x2 __attribute__((ext_vector_type(2)));
typedef unsigned u32x2 __attribute__((ext_vector_type(2)));
constexpr int DM_ = 1024, DFF_ = 2816, LDQKV_ = 1536, LDG_ = 2048;
constexpr float LOG2E_ = 1.4426950408889634f;
constexpr float QSCALE_ = 0.125f * 1.4426950408889634f;
__device__ __forceinline__ float sigm(float x) { return __builtin_amdgcn_rcpf(1.f + __builtin_amdgcn_exp2f(-LOG2E_ * x)); }
__device__ __forceinline__ float bf_lo(unsigned w) { return __uint_as_float(w << 16); }
__device__ __forceinline__ float bf_hi(unsigned w) { return __uint_as_float(w & 0xffff0000u); }
__device__ __forceinline__ u32x4 pack8(const f32x4 a, const f32x4 b) { u32x4 w; w.x = cvt_pk_bf16(a[0], a[1]); w.y = cvt_pk_bf16(a[2], a[3]); w.z = cvt_pk_bf16(b[0], b[1]); w.w = cvt_pk_bf16(b[2], b[3]); return w; }


__device__ __forceinline__ void row_rstd(const float* SS, int row0, int fq, float (&rs)[2][4]) {
    f32x4 pv[2][4];
#pragma unroll
    for (int ai = 0; ai < 2; ++ai)
#pragma unroll
        for (int m = 0; m < 4; ++m) pv[ai][m] = *(const f32x4*)(SS + (size_t)(row0 + ai * HALF + m * 16) * 16 + 4 * fq);
#pragma unroll
    for (int ai = 0; ai < 2; ++ai)
#pragma unroll
        for (int m = 0; m < 4; ++m) { float s = (pv[ai][m][0] + pv[ai][m][1]) + (pv[ai][m][2] + pv[ai][m][3]); s += __shfl_xor(s, 16); s += __shfl_xor(s, 32);
            rs[ai][m] = 1.0f / sqrtf(s * (1.0f / 1024.0f) + 1e-6f); }
}

struct EpiSwiglu {
    static constexpr bool PERM = true, AFTER_DRAIN = false, MID = false;
    bf16_t* T; const float* SS;
    __device__ __forceinline__ void operator()(const f32x4 (&acc)[2][2][4][2], const Unit& u, int wr, int wc, int fr, int fq) const {
        const int row0 = u.pm * BM + wr * 64 + fr, col0 = u.pn * 128 + wc * 32 + 8 * fq;
        float rs[2][4]; row_rstd(SS, row0, fq, rs);
#pragma unroll
        for (int ai = 0; ai < 2; ++ai)
#pragma unroll
            for (int m = 0; m < 4; ++m) {
                bf16_t* rowp = T + (size_t)(row0 + ai * HALF + m * 16) * DFF_ + col0;
                f32x4 v[2];
#pragma unroll
                for (int n = 0; n < 2; ++n)
#pragma unroll
                    for (int i = 0; i < 4; ++i) { const float a = acc[ai][0][m][n][i] * rs[ai][m], b = acc[ai][1][m][n][i] * rs[ai][m]; v[n][i] = a * sigm(a) * b; }
                *(u32x4*)rowp = pack8(v[0], v[1]);
            }
    }
};
struct EpiResid {
    static constexpr bool PERM = true, AFTER_DRAIN = false, MID = false;
    float* xout; float s; bf16_t* XB; float* SS; int final_;
    __device__ __forceinline__ void operator()(const f32x4 (&acc)[2][2][4][2], const Unit& u, int wr, int wc, int fr, int fq) const {
        const int col0 = u.pn * BM + wc * 32 + 8 * fq;
        u32x4 xall[2][4][2];
#pragma unroll
        for (int ai = 0; ai < 2; ++ai)
#pragma unroll
            for (int m = 0; m < 4; ++m)
#pragma unroll
                for (int bj = 0; bj < 2; ++bj) xall[ai][m][bj] = *(const u32x4*)(XB + (size_t)(u.pm * BM + ai * HALF + wr * 64 + m * 16 + fr) * DM_ + col0 + bj * HALF);
#pragma unroll
        for (int ai = 0; ai < 2; ++ai)
#pragma unroll
            for (int m = 0; m < 4; ++m) {
                const int row = u.pm * BM + ai * HALF + wr * 64 + m * 16 + fr;
                const size_t off = (size_t)row * DM_ + col0;
                u32x4 xb[2];
#pragma unroll
                for (int bj = 0; bj < 2; ++bj) xb[bj] = xall[ai][m][bj];
                float ss = 0.f;
#pragma unroll
                for (int bj = 0; bj < 2; ++bj) {
                    f32x4 xv[2];
#pragma unroll
                    for (int w = 0; w < 4; ++w) { xv[w >> 1][(w & 1) * 2] = bf_lo(xb[bj][w]) + acc[ai][bj][m][w >> 1][(w & 1) * 2] * s; xv[w >> 1][(w & 1) * 2 + 1] = bf_hi(xb[bj][w]) + acc[ai][bj][m][w >> 1][(w & 1) * 2 + 1] * s; }
                    if (final_) { *(f32x4*)(xout + off + bj * HALF) = xv[0]; *(f32x4*)(xout + off + bj * HALF + 4) = xv[1]; }
                    else {
#pragma unroll
                        for (int n = 0; n < 2; ++n) ss += (xv[n][0] * xv[n][0] + xv[n][1] * xv[n][1]) + (xv[n][2] * xv[n][2] + xv[n][3] * xv[n][3]);
                        *(u32x4*)(XB + off + bj * HALF) = pack8(xv[0], xv[1]);
                    }
                }
                if (!final_) { ss += __shfl_xor(ss, 16); ss += __shfl_xor(ss, 32); if (fq == 0) SS[(size_t)row * 16 + u.pn * 4 + wc] = ss; }
                asm volatile("" ::: "memory");
            }
    }
};
struct EpiQKV {
    static constexpr bool PERM = true, AFTER_DRAIN = false, MID = false;
    bf16_t* QA; bf16_t* QB; const float* gn; const float* rope; const float* SS;
    __device__ __forceinline__ void operator()(const f32x4 (&acc)[2][2][4][2], const Unit& u, int wr, int wc, int fr, int fq) const {
        const int part = u.pn >> 1, sub = u.pn & 1, p3 = part % 3;
        bf16_t* dst = (part < 3) ? QA : QB;
        const int pcol = p3 * 512 + sub * 256 + wc * 64 + 8 * fq;
        const bool isqk = (p3 != 2), isq = (p3 == 0), dorope = (part >= 3) && isqk;
        const float* g = gn + part * 64;
        f32x4 gv[2][2];
#pragma unroll
        for (int bj = 0; bj < 2; ++bj)
#pragma unroll
            for (int n = 0; n < 2; ++n) gv[bj][n] = *(const f32x4*)(g + 32 * bj + 8 * fq + 4 * n);
        float rsx[2][4]; row_rstd(SS, u.pm * BM + wr * 64 + fr, fq, rsx);
#pragma unroll
        for (int ai = 0; ai < 2; ++ai)
#pragma unroll
            for (int m = 0; m < 4; ++m) {
                const int row = u.pm * BM + ai * HALF + wr * 64 + m * 16 + fr;
                f32x4 v[2][2];
#pragma unroll
                for (int bj = 0; bj < 2; ++bj)
#pragma unroll
                    for (int n = 0; n < 2; ++n) v[bj][n] = acc[ai][bj][m][n] * rsx[ai][m];
                if (isqk) {
                    float ss = 0.f;
#pragma unroll
                    for (int bj = 0; bj < 2; ++bj)
#pragma unroll
                        for (int n = 0; n < 2; ++n) ss += (v[bj][n][0] * v[bj][n][0] + v[bj][n][1] * v[bj][n][1]) + (v[bj][n][2] * v[bj][n][2] + v[bj][n][3] * v[bj][n][3]);
                    ss += __shfl_xor(ss, 16); ss += __shfl_xor(ss, 32);
                    const float rs = 1.0f / sqrtf(ss * (1.0f / 64.0f) + 1e-6f);
#pragma unroll
                    for (int bj = 0; bj < 2; ++bj)
#pragma unroll
                        for (int n = 0; n < 2; ++n) v[bj][n] = v[bj][n] * rs * gv[bj][n];
                    if (dorope) {
                        const int pos = (row < 16384) ? row : ((row - 16384) & 4095);
                        const float* cs = rope + (size_t)pos * 16;
#pragma unroll
                        for (int n = 0; n < 2; ++n) {
                            const f32x4 c = *(const f32x4*)(cs + 4 * n), s = *(const f32x4*)(cs + 8 + 4 * n);
                            const f32x4 me = v[0][n]; f32x4 ot;
#pragma unroll
                            for (int i = 0; i < 4; ++i) ot[i] = __shfl_xor(me[i], 16);
                            const f32x4 r0 = me * c - ot * s, r1 = me * c + ot * s;
                            if (fq == 0) v[0][n] = r0; else if (fq == 1) v[0][n] = r1;
                        }
                    }
                    if (isq) {
#pragma unroll
                        for (int bj = 0; bj < 2; ++bj)
#pragma unroll
                            for (int n = 0; n < 2; ++n) v[bj][n] = v[bj][n] * QSCALE_;
                    }
                }
                bf16_t* rowp = dst + (size_t)row * LDQKV_ + pcol;
#pragma unroll
                for (int bj = 0; bj < 2; ++bj) *(u32x4*)(rowp + 32 * bj) = pack8(v[bj][0], v[bj][1]);
            }
    }
};
struct EpiY {
    static constexpr bool PERM = true, AFTER_DRAIN = false, MID = false;
    bf16_t* Y;
    __device__ __forceinline__ void operator()(const f32x4 (&acc)[2][2][4][2], const Unit& u, int wr, int wc, int fr, int fq) const {
        const int row0 = u.pm * BM + wr * 64 + fr, col0 = u.pn * BM + wc * 32 + 8 * fq;
#pragma unroll
        for (int ai = 0; ai < 2; ++ai)
#pragma unroll
            for (int m = 0; m < 4; ++m) {
                bf16_t* rowp = Y + (size_t)(row0 + ai * HALF + m * 16) * LDG_ + col0;
#pragma unroll
                for (int bj = 0; bj < 2; ++bj) *(u32x4*)(rowp + bj * HALF) = pack8(acc[ai][bj][m][0], acc[ai][bj][m][1]);
            }
    }
};
struct EpiGateMerge {
    static constexpr bool PERM = true, AFTER_DRAIN = false, MID = false;
    const bf16_t* Y; bf16_t* MG; const float* SS;
    __device__ __forceinline__ void operator()(const f32x4 (&acc)[2][2][4][2], const Unit& u, int wr, int wc, int fr, int fq) const {
        const int row0 = u.pm * BM + wr * 64 + fr, col0 = u.pn * 128 + wc * 32 + 8 * fq;
        float rs[2][4]; row_rstd(SS, row0, fq, rs);
#pragma unroll
        for (int ai = 0; ai < 2; ++ai) {
            u32x4 ya[4], yb[4];
#pragma unroll
            for (int m = 0; m < 4; ++m) { const bf16_t* yp = Y + (size_t)(row0 + ai * HALF + m * 16) * LDG_ + col0; ya[m] = *(const u32x4*)yp; yb[m] = *(const u32x4*)(yp + 1024); }
#pragma unroll
            for (int m = 0; m < 4; ++m) {
                f32x4 v[2];
#pragma unroll
                for (int w = 0; w < 4; ++w) {
                    const int n = w >> 1, i0 = (w & 1) * 2;
                    v[n][i0]     = sigm(acc[ai][0][m][n][i0]     * rs[ai][m]) * bf_lo(ya[m][w]) + sigm(acc[ai][1][m][n][i0]     * rs[ai][m]) * bf_lo(yb[m][w]);
                    v[n][i0 + 1] = sigm(acc[ai][0][m][n][i0 + 1] * rs[ai][m]) * bf_hi(ya[m][w]) + sigm(acc[ai][1][m][n][i0 + 1] * rs[ai][m]) * bf_hi(yb[m][w]);
                }
                *(u32x4*)(MG + (size_t)(row0 + ai * HALF + m * 16) * DM_ + col0) = pack8(v[0], v[1]);
            }
            asm volatile("" ::: "memory");
        }
    }
};
template <class Epi, class Sched, bool ALIGN_EPI = false, bool SP2 = false>
__device__ __forceinline__ void gemm_phase(PG8_LAS unsigned char* lds, const Gemm g, const Sched& S, const Epi& E) {
    int tid_ = threadIdx.x; asm volatile("" : "+v"(tid_));
    const int tid = tid_, wid = __builtin_amdgcn_readfirstlane(tid >> 6), lane = tid & 63, wr = wid >> 2, wc = wid & 3, fr = lane & 15, fq = lane >> 4;
    const int K = g.K, nt = K / BK, lda = g.lda ? g.lda : g.K;
    unsigned voffA[2], voffB[2];
#pragma unroll
    for (int i = 0; i < 2; ++i) { int R, C; stage_rc(tid * 16 + i * 8192, R, C); const int Rb = Epi::PERM ? ((R & ~31) + perm32(R & 31)) : R;
        voffA[i] = (unsigned)(R * lda + C) * 2u; voffB[i] = (unsigned)(Rb * K + C) * 2u; }
    const size_t kstep = (size_t)(BK * 2);
    const size_t hstep = (size_t)HALF * K * 2;
    const size_t tstep = 2 * hstep;
    const size_t hstepA = (size_t)HALF * lda * 2, tstepA = 2 * hstepA;
    const unsigned ldsw = (unsigned)wid * 1024u;
    const int aoff = lds_byte(wr * 64 + fr, fq * 8), boff = lds_byte(wc * 32 + fr, fq * 8);
#define PG8_SA(b, h) (((b) * 2 + (h)) * HTB)
#define PG8_SB(b, h) ((4 + (b) * 2 + (h)) * HTB)
#define PG8_STAGE(bufoff, gbase, voff) do { _Pragma("unroll") for (int _i = 0; _i < 2; ++_i) \
        __builtin_amdgcn_global_load_lds((const unsigned*)((const char*)(gbase) + (voff)[_i]), (PG8_LAS unsigned*)(lds + (bufoff) + ldsw + _i * 8192), 16, 0, 0); } while (0)
#define PG8_LDA(dst, b, h) do { _Pragma("unroll") for (int m = 0; m < 4; ++m) _Pragma("unroll") for (int k = 0; k < 2; ++k) dst[m][k] = *(const PG8_LAS bf16x8*)(lds + PG8_SA(b, h) + aoff + m * 2048 + k * 1024); } while (0)
#define PG8_LDB(dst, b, h) do { _Pragma("unroll") for (int n = 0; n < 2; ++n) _Pragma("unroll") for (int k = 0; k < 2; ++k) dst[n][k] = *(const PG8_LAS bf16x8*)(lds + PG8_SB(b, h) + boff + n * 2048 + k * 1024); } while (0)
#define PG8_MMA(ai, bj, At, Bt) do { __builtin_amdgcn_s_setprio(1); _Pragma("unroll") for (int m = 0; m < 4; ++m) _Pragma("unroll") for (int n = 0; n < 2; ++n) _Pragma("unroll") for (int k = 0; k < 2; ++k) \
        acc[ai][bj][m][n] = __builtin_amdgcn_mfma_f32_16x16x32_bf16(Bt[n][k], At[m][k], acc[ai][bj][m][n], 0, 0, 0); __builtin_amdgcn_s_setprio(0); } while (0)
#define PG8_WAIT_V(n) asm volatile("s_waitcnt vmcnt(" #n ")" ::: "memory")
#define PG8_WAIT_L(n) asm volatile("s_waitcnt lgkmcnt(" #n ")" ::: "memory")
#define PG8_BAR __builtin_amdgcn_s_barrier()
#define PG8_SCHED __builtin_amdgcn_sched_barrier(0)
    Unit cur, nxt; int ui = 0;
    if (!S.next(0, cur)) return;
    f32x4 acc[2][2][4][2];
#pragma unroll
    for (int a = 0; a < 2; ++a)
#pragma unroll
        for (int b = 0; b < 2; ++b)
#pragma unroll
            for (int m = 0; m < 4; ++m)
#pragma unroll
                for (int n = 0; n < 2; ++n) acc[a][b][m][n] = (f32x4){0.f, 0.f, 0.f, 0.f};
    bf16x8 At[4][2], B0[2][2], B1[2][2];
    const char* cA = (const char*)g.A + (size_t)cur.pm * tstepA + (size_t)(cur.pn >> 2) * g.aselb; const char* cB = (const char*)g.Bt + (size_t)cur.pn * tstep;
    S.a_ready(cur);
    if constexpr (SP2) {
        PG8_STAGE(PG8_SB(0, 0), cB, voffB); PG8_STAGE(PG8_SB(0, 1), cB + hstep, voffB); PG8_STAGE(PG8_SA(0, 0), cA, voffA); PG8_STAGE(PG8_SA(0, 1), cA + hstepA, voffA);
        if (wr == 1) PG8_BAR;
        PG8_WAIT_V(2); PG8_BAR;
        PG8_STAGE(PG8_SB(1, 0), cB + kstep, voffB); PG8_STAGE(PG8_SA(1, 0), cA + kstep, voffA); PG8_STAGE(PG8_SB(1, 1), cB + hstep + kstep, voffB);
        PG8_WAIT_V(6); PG8_BAR;
    } else {
        PG8_STAGE(PG8_SB(0, 0), cB, voffB); PG8_STAGE(PG8_SA(0, 0), cA, voffA); PG8_STAGE(PG8_SB(0, 1), cB + hstep, voffB); PG8_STAGE(PG8_SA(0, 1), cA + hstepA, voffA);
        if (wr == 1) PG8_BAR;
        PG8_WAIT_V(4); PG8_BAR;
        PG8_STAGE(PG8_SB(1, 0), cB + kstep, voffB); PG8_STAGE(PG8_SA(1, 0), cA + kstep, voffA); PG8_STAGE(PG8_SB(1, 1), cB + hstep + kstep, voffB);
        PG8_WAIT_V(6); PG8_BAR;
    }
    for (;;) {
        const bool has_next = S.next(ui + 1, nxt);
        const char* nA = has_next ? (const char*)g.A + (size_t)nxt.pm * tstepA + (size_t)(nxt.pn >> 2) * g.aselb : cA; const char* nB = has_next ? (const char*)g.Bt + (size_t)nxt.pn * tstep : cB;
        for (int t = 0; t < nt; t += 2) {
            if constexpr (Epi::MID) { if (t == (nt >> 1)) E.mid(acc, cur, wr, wc, fr, fq); }
            const bool last = (t == nt - 2);
            const char* a1 = cA + (size_t)(t + 1) * kstep;
            const char* a2 = last ? nA : cA + (size_t)(t + 2) * kstep; const char* b2 = last ? nB : cB + (size_t)(t + 2) * kstep;
            const char* a3 = a2 + kstep; const char* b3 = b2 + kstep;
            if (last && has_next) S.a_ready(nxt);
            if constexpr (SP2) {
            PG8_LDB(B0, 0, 0); PG8_LDB(B1, 0, 1); PG8_SCHED; PG8_LDA(At, 0, 0); PG8_STAGE(PG8_SA(1, 1), a1 + hstepA, voffA);
            PG8_WAIT_V(8); PG8_WAIT_L(0); PG8_BAR; PG8_MMA(0, 0, At, B0); PG8_MMA(0, 1, At, B1); PG8_BAR; PG8_SCHED;
            PG8_LDA(At, 0, 1); PG8_STAGE(PG8_SB(0, 0), b2, voffB); PG8_STAGE(PG8_SB(0, 1), b2 + hstep, voffB); PG8_STAGE(PG8_SA(0, 0), a2, voffA);
            PG8_WAIT_V(8); PG8_WAIT_L(0); PG8_BAR; PG8_MMA(1, 0, At, B0); PG8_MMA(1, 1, At, B1); PG8_BAR; PG8_SCHED;
            PG8_LDB(B0, 1, 0); PG8_LDB(B1, 1, 1); PG8_SCHED; PG8_LDA(At, 1, 0); PG8_STAGE(PG8_SA(0, 1), a2 + hstepA, voffA);
            PG8_WAIT_V(8); PG8_WAIT_L(0); PG8_BAR; PG8_MMA(0, 0, At, B0); PG8_MMA(0, 1, At, B1); PG8_BAR; PG8_SCHED;
            PG8_LDA(At, 1, 1); PG8_STAGE(PG8_SB(1, 0), b3, voffB); PG8_STAGE(PG8_SB(1, 1), b3 + hstep, voffB); PG8_STAGE(PG8_SA(1, 0), a3, voffA);
            PG8_WAIT_V(8); PG8_WAIT_L(0); PG8_BAR; PG8_MMA(1, 0, At, B0); PG8_MMA(1, 1, At, B1); PG8_BAR; PG8_SCHED;
            } else {
            PG8_LDB(B0, 0, 0); PG8_SCHED; PG8_LDA(At, 0, 0); PG8_STAGE(PG8_SA(1, 1), a1 + hstepA, voffA);
            PG8_WAIT_L(8); PG8_BAR; PG8_WAIT_L(0); PG8_MMA(0, 0, At, B0); PG8_BAR; PG8_SCHED;
            PG8_LDB(B1, 0, 1); PG8_STAGE(PG8_SB(0, 0), b2, voffB);
            PG8_BAR; PG8_WAIT_L(0); PG8_MMA(0, 1, At, B1); PG8_BAR;
            PG8_LDA(At, 0, 1); PG8_STAGE(PG8_SA(0, 0), a2, voffA);
            PG8_BAR; PG8_WAIT_L(0); PG8_MMA(1, 0, At, B0); PG8_BAR; PG8_SCHED;
            PG8_STAGE(PG8_SB(0, 1), b2 + hstep, voffB);
            PG8_WAIT_V(6); PG8_BAR; PG8_MMA(1, 1, At, B1); PG8_BAR;
            PG8_LDB(B0, 1, 0); PG8_SCHED; PG8_LDA(At, 1, 0); PG8_STAGE(PG8_SA(0, 1), a2 + hstepA, voffA);
            PG8_WAIT_L(8); PG8_BAR; PG8_WAIT_L(0); PG8_MMA(0, 0, At, B0); PG8_BAR; PG8_SCHED;
            PG8_LDB(B1, 1, 1); PG8_STAGE(PG8_SB(1, 0), b3, voffB);
            PG8_BAR; PG8_WAIT_L(0); PG8_MMA(0, 1, At, B1); PG8_BAR;
            PG8_LDA(At, 1, 1); PG8_STAGE(PG8_SA(1, 0), a3, voffA);
            PG8_BAR; PG8_WAIT_L(0); PG8_MMA(1, 0, At, B0); PG8_BAR; PG8_SCHED;
            PG8_STAGE(PG8_SB(1, 1), b3 + hstep, voffB);
            PG8_WAIT_V(6); PG8_BAR; PG8_MMA(1, 1, At, B1); PG8_BAR;
            }
        }
        if constexpr (ALIGN_EPI) { if (wr == 0) PG8_BAR; }
        if constexpr (!Epi::AFTER_DRAIN) { E(acc, cur, wr, wc, fr, fq); S.done(cur); }
        if (!has_next) break;
#pragma unroll
        for (int a = 0; a < 2; ++a)
#pragma unroll
            for (int b = 0; b < 2; ++b)
#pragma unroll
                for (int m = 0; m < 4; ++m)
#pragma unroll
                    for (int n = 0; n < 2; ++n) acc[a][b][m][n] = (f32x4){0.f, 0.f, 0.f, 0.f};
        cur = nxt; cA = nA; cB = nB; ++ui;
        if constexpr (ALIGN_EPI) { if (wr == 1) PG8_BAR; }
    }
    PG8_WAIT_V(0);
    if constexpr (!ALIGN_EPI) { if (wr == 0) PG8_BAR; }
    PG8_BAR;
    if constexpr (Epi::AFTER_DRAIN) { E.fused(acc, cur, wr, wc, fr, fq, lds, wid, lane); S.done(cur); }
#undef PG8_SA
#undef PG8_SB
#undef PG8_STAGE
#undef PG8_LDA
#undef PG8_LDB
#undef PG8_MMA
#undef PG8_WAIT_V
#undef PG8_WAIT_L
#undef PG8_BAR
#undef PG8_SCHED
}
}
namespace att {
#define ALAS __attribute__((address_space(3)))
typedef unsigned short bf16_t;
using bf16x8 = __attribute__((ext_vector_type(8))) short;
using s16x4  = __attribute__((ext_vector_type(4))) short;
using f32x16 = __attribute__((ext_vector_type(16))) float;
using u32x4  = __attribute__((ext_vector_type(4))) unsigned;
constexpr int LD = 1536;
constexpr int SHM_K = 8192, SHM_V = 16384;
constexpr int L_V = 0, L_K = 2 * SHM_V, L_WS = L_K + 2 * SHM_K, L_TAB = L_WS + 2048, L_STASH = L_TAB + 2048, L_END = L_STASH + 65536;
constexpr float THR2 = 8.f;
#define KSWZ(row, colB) ((row) * 128 + ((colB) ^ ((((row) >> 1) & 7) << 4)))
#define SBAR() __builtin_amdgcn_sched_barrier(0)
__device__ __forceinline__ int crow(int r, int hi) { return (r & 3) + 8 * (r >> 2) + 4 * hi; }
typedef float f32x2c_ __attribute__((ext_vector_type(2))); typedef __bf16 bf16x2c_ __attribute__((ext_vector_type(2)));
__device__ __forceinline__ unsigned cvtpk(float lo, float hi) { f32x2c_ v = {lo, hi}; bf16x2c_ b = __builtin_convertvector(v, bf16x2c_); return __builtin_bit_cast(unsigned, b); }

struct NaCtx { int klo, rq, s0q, qc, wstart; const ALAS float* tab; };
__device__ __forceinline__ void na_bias(f32x16& p0, f32x16& p1, int t, int hi, const NaCtx& c) {
  const int kr = c.klo + t; const bool active = (kr >= c.s0q) && (kr <= c.s0q + 7);
  if (!active) {
#pragma unroll
    for (int r = 0; r < 16; ++r) { p0[r] = -1e30f; p1[r] = -1e30f; }
    return;
  }
  const int tb = (kr - c.rq + 7) * 32 + 15 - c.qc;
#pragma unroll
  for (int r = 0; r < 16; ++r) {
    const int kc = crow(r, hi);
    { const bool v = (unsigned)(kc - c.wstart) < 16u; const float b = c.tab[v ? tb + kc : 0]; p0[r] = v ? p0[r] + b : -1e30f; }
    { const int k2 = kc + 32; const bool v = (unsigned)(k2 - c.wstart) < 16u; const float b = c.tab[v ? tb + k2 : 0]; p1[r] = v ? p1[r] + b : -1e30f; }
  }
}
__device__ __forceinline__ void k_issue(bf16x8 (&kf)[8], const ALAS char* Ks, int r32, int hi) {
#pragma unroll
  for (int d0 = 0; d0 < 4; ++d0) { const int cb = (d0 * 16 + hi * 8) * 2;
    kf[2 * d0] = *(const ALAS bf16x8*)(Ks + KSWZ(r32, cb)); kf[2 * d0 + 1] = *(const ALAS bf16x8*)(Ks + KSWZ(32 + r32, cb)); }
}
__device__ __forceinline__ void qkt(f32x16& p0, f32x16& p1, const bf16x8 (&kf)[8], const bf16x8* qr, const f32x16& cinit) {
  p0 = __builtin_amdgcn_mfma_f32_32x32x16_bf16(kf[0], qr[0], cinit, 0, 0, 0); p1 = __builtin_amdgcn_mfma_f32_32x32x16_bf16(kf[1], qr[0], cinit, 0, 0, 0);
#pragma unroll
  for (int d0 = 1; d0 < 4; ++d0) { p0 = __builtin_amdgcn_mfma_f32_32x32x16_bf16(kf[2 * d0], qr[d0], p0, 0, 0, 0); p1 = __builtin_amdgcn_mfma_f32_32x32x16_bf16(kf[2 * d0 + 1], qr[d0], p1, 0, 0, 0); }
}
template <int NC> __device__ __forceinline__ int v_st(int k, int c) { const int kk = (k & ~0xC) | ((k & 4) << 1) | ((k & 8) >> 1); return ((kk >> 3) * NC + (c >> 5)) * 512 + ((kk & 7) * 32 + (c & 31)) * 2; }
__device__ __forceinline__ int v_rd_base(int lane) { return ((lane & 3) << 3) | (((lane >> 2) & 3) << 6) | (((lane >> 4) & 1) << 5) | (((lane >> 5) & 1) << 8); }
template <int NC> constexpr int v_rd_off(int d0, int ks, int half) { return d0 * 512 + (2 * ks + half) * NC * 512; }
template <int OFF> __device__ __forceinline__ s16x4 tr_read(int vb) {
  s16x4 r; asm volatile("ds_read_b64_tr_b16 %0, %1 offset:%2" : "=&v"(r) : "v"(vb), "i"(OFF) : "memory"); return r;
}
template <int NC, int KS> __device__ __forceinline__ void v_issue_k(s16x4 (&L)[8], int vb) {
  L[0] = tr_read<v_rd_off<NC>(0, KS, 0)>(vb); L[1] = tr_read<v_rd_off<NC>(0, KS, 1)>(vb); L[2] = tr_read<v_rd_off<NC>(1, KS, 0)>(vb); L[3] = tr_read<v_rd_off<NC>(1, KS, 1)>(vb);
  if constexpr (NC == 4) { L[4] = tr_read<v_rd_off<NC>(2, KS, 0)>(vb); L[5] = tr_read<v_rd_off<NC>(2, KS, 1)>(vb); L[6] = tr_read<v_rd_off<NC>(3, KS, 0)>(vb); L[7] = tr_read<v_rd_off<NC>(3, KS, 1)>(vb); }
}
template <int NC> __device__ __forceinline__ void v_mma_k(f32x16* o, f32x16& osum, const s16x4 (&L)[8], bf16x8 pa, bf16x8 ones) {
#define PK(A, B) (bf16x8){A[0], A[1], A[2], A[3], B[0], B[1], B[2], B[3]}
  osum = __builtin_amdgcn_mfma_f32_32x32x16_bf16(pa, ones, osum, 0, 0, 0);
  o[0] = __builtin_amdgcn_mfma_f32_32x32x16_bf16(pa, PK(L[0], L[1]), o[0], 0, 0, 0);
  o[1] = __builtin_amdgcn_mfma_f32_32x32x16_bf16(pa, PK(L[2], L[3]), o[1], 0, 0, 0);
  if constexpr (NC == 4) { o[2] = __builtin_amdgcn_mfma_f32_32x32x16_bf16(pa, PK(L[4], L[5]), o[2], 0, 0, 0); o[3] = __builtin_amdgcn_mfma_f32_32x32x16_bf16(pa, PK(L[6], L[7]), o[3], 0, 0, 0); }
#undef PK
}
template <int DV, bool NA>
__device__ __forceinline__ void attn_core(const bf16_t* __restrict__ Qlane, const bf16_t* __restrict__ Kh, const bf16_t* __restrict__ Vh, const int NT,
                                          ALAS char* lds, f32x16 (&o)[DV / 32], const NaCtx& na) {
  constexpr int NC = DV / 32;
  int tid_ = threadIdx.x; asm volatile("" : "+v"(tid_));
  const int tid = tid_, wid = __builtin_amdgcn_readfirstlane(tid >> 6), lane = tid & 63, r32 = lane & 31, hi = lane >> 5;
  ALAS char* V_lds = lds + L_V; ALAS char* K_lds = lds + L_K;
  ALAS float* al_l = (ALAS float*)(lds + L_WS) + wid * 64;
  float m_ref = 0.f;
  f32x16 osum = f32x16{}, negm = f32x16{};
#pragma unroll
  for (int d = 0; d < NC; ++d) o[d] = f32x16{};
  bf16x8 qr[4];
#pragma unroll
  for (int d0 = 0; d0 < 4; ++d0) qr[d0] = *reinterpret_cast<const bf16x8*>(Qlane + d0 * 16);
  const bf16x8 ones = {0x3f80, 0x3f80, 0x3f80, 0x3f80, 0x3f80, 0x3f80, 0x3f80, 0x3f80};
  const int kr_ = tid >> 3, kc8 = (tid & 7) * 8, kst = KSWZ(kr_, kc8 * 2);
  const int vr_ = (DV == 128) ? (tid >> 4) : (tid >> 3), vc8 = (DV == 128) ? (tid & 15) * 8 : (tid & 7) * 8;
  const int vst0 = v_st<NC>(vr_, vc8), vst1 = v_st<NC>((32 + vr_) & 63, vc8);
  const int vb0 = (int)(uintptr_t)V_lds + v_rd_base(lane);
  const int kgo = kr_ * LD + kc8, vgo = vr_ * LD + vc8;
  bf16x8 sk0, sva0, svb0, sk1, sva1, svb1;
#define SLOADX(S, k0) do { sk##S = *reinterpret_cast<const bf16x8*>(Kh + (long)(k0) * LD + kgo); sva##S = *reinterpret_cast<const bf16x8*>(Vh + (long)(k0) * LD + vgo); \
    if constexpr (DV == 128) svb##S = *reinterpret_cast<const bf16x8*>(Vh + (long)((k0) + 32) * LD + vgo); } while (0)
#define SWRITEX(S, b) do { *(ALAS bf16x8*)(V_lds + (b) * SHM_V + vst0) = sva##S; if constexpr (DV == 128) *(ALAS bf16x8*)(V_lds + (b) * SHM_V + vst1) = svb##S; \
    *(ALAS bf16x8*)(K_lds + (b) * SHM_K + kst) = sk##S; } while (0)
#define ACT(t) (!NA || ((na.klo + (t)) >= na.s0q && (na.klo + (t)) <= na.s0q + 7))
  SLOADX(0, 0); asm volatile("s_waitcnt vmcnt(0)" ::: "memory"); SWRITEX(0, 0); SLOADX(1, 64); SLOADX(0, 128); __syncthreads();
  for (int jj = 0; jj < NT; jj += 2) {
#pragma unroll
   for (int par = 0; par < 2; ++par) {
    const int j = jj + par; const int b = par; const bool act = ACT(j);
    bf16x8 kf[8];
    if (act) k_issue(kf, K_lds + b * SHM_K, r32, hi);
    if (par == 0) { if (j + 1 < NT) { SWRITEX(1, 1); if (j + 3 < NT) SLOADX(1, (j + 3) * 64); } }
    else          { if (j + 1 < NT) { SWRITEX(0, 0); if (j + 3 < NT) SLOADX(0, (j + 3) * 64); } }
    if (act) {
      f32x16 p0, p1;
      qkt(p0, p1, kf, qr, negm);
      if constexpr (NA) na_bias(p0, p1, j, hi, na);
      float pmax = fmaxf(p0[0], p1[0]), pmx2 = fmaxf(p0[1], p1[1]);
#pragma unroll
      for (int r = 2; r < 16; r += 2) { pmax = __builtin_fmaxf(__builtin_fmaxf(pmax, p0[r]), p1[r]); pmx2 = __builtin_fmaxf(__builtin_fmaxf(pmx2, p0[r + 1]), p1[r + 1]); }
      pmax = fmaxf(pmax, pmx2);
      { auto rr = __builtin_amdgcn_permlane32_swap(__float_as_uint(pmax), __float_as_uint(pmax), false, false);
        pmax = fmaxf(__uint_as_float(rr[0]), __uint_as_float(rr[1])); }
      if (__builtin_expect(!__all(pmax <= THR2), 0)) {
        const float dl = fmaxf(pmax, 0.f); m_ref += dl;
#pragma unroll
        for (int r = 0; r < 16; ++r) { p0[r] -= dl; p1[r] -= dl; negm[r] = -m_ref; }
        const float f = __builtin_amdgcn_exp2f(-dl);
        if (hi == 0) al_l[r32] = f; asm volatile("s_waitcnt lgkmcnt(0)" ::: "memory");
#pragma unroll
        for (int r = 0; r < 16; ++r) { const float ar = al_l[crow(r, hi)]; osum[r] *= ar;
#pragma unroll
          for (int d = 0; d < NC; ++d) o[d][r] *= ar; }
      }
      const int vb = vb0 + b * SHM_V;
      s16x4 LA[8], LB[8]; bf16x8 pa;
#define PK4(P, BASE, OUT) do { unsigned a0 = cvtpk(P[BASE + 0], P[BASE + 1]), a1 = cvtpk(P[BASE + 2], P[BASE + 3]);   \
    unsigned b0 = cvtpk(P[BASE + 4], P[BASE + 5]), b1 = cvtpk(P[BASE + 6], P[BASE + 7]);                              \
    auto r0 = __builtin_amdgcn_permlane32_swap(a0, b0, false, false); auto r1 = __builtin_amdgcn_permlane32_swap(a1, b1, false, false); \
    u32x4 w = {r0[0], r1[0], r0[1], r1[1]}; OUT = *reinterpret_cast<bf16x8*>(&w); } while (0)
#define EXP8(P, BASE) do { _Pragma("unroll") for (int r = 0; r < 8; ++r) P[BASE + r] = __builtin_amdgcn_exp2f(P[BASE + r]); } while (0)
#define LGKM(n) asm volatile("s_waitcnt lgkmcnt(" #n ")" ::: "memory")
      v_issue_k<NC, 0>(LA, vb);
      EXP8(p0, 0); PK4(p0, 0, pa); SBAR();
      v_issue_k<NC, 1>(LB, vb); if constexpr (NC == 4) LGKM(8); else LGKM(4); SBAR(); v_mma_k<NC>(o, osum, LA, pa, ones); SBAR();
      EXP8(p0, 8); PK4(p0, 8, pa); SBAR();
      v_issue_k<NC, 2>(LA, vb); if constexpr (NC == 4) LGKM(8); else LGKM(4); SBAR(); v_mma_k<NC>(o, osum, LB, pa, ones); SBAR();
      EXP8(p1, 0); PK4(p1, 0, pa); SBAR();
      v_issue_k<NC, 3>(LB, vb); if constexpr (NC == 4) LGKM(8); else LGKM(4); SBAR(); v_mma_k<NC>(o, osum, LA, pa, ones); SBAR();
      EXP8(p1, 8); PK4(p1, 8, pa); SBAR();
      LGKM(0); SBAR(); v_mma_k<NC>(o, osum, LB, pa, ones);
#undef PK4
#undef EXP8
#undef LGKM
    }
    __syncthreads();
   }
  }
#pragma unroll
  for (int r = 0; r < 16; ++r) { const float rl = __builtin_amdgcn_rcpf(osum[r]);
#pragma unroll
    for (int d = 0; d < NC; ++d) o[d][r] *= rl; }
#undef SLOADX
#undef SWRITEX
#undef ACT
}
__device__ __forceinline__ bf16_t to_bf16(float v) { return (bf16_t)(cvtpk(v, 0.f) & 0xffffu); }

constexpr int NAW_V = 0, NAW_TAB = 131072, NAW_TSTRIDE = 2000, NAW_END = NAW_TAB + 8 * NAW_TSTRIDE;
__device__ __forceinline__ void na_wave_units(int gw, int NGW, const bf16_t* QA, bf16_t* AB, const float* rpb  , ALAS char* lds) {
  int tid_ = threadIdx.x; asm volatile("" : "+v"(tid_));
  const int tid = tid_, wid = __builtin_amdgcn_readfirstlane(tid >> 6), lane = tid & 63, r32 = lane & 31, hi = lane >> 5;
  const int h = gw & 7;
  ALAS char* Vw = lds + NAW_V + wid * 16384;
  ALAS float* tab = (ALAS float*)(lds + NAW_TAB + wid * NAW_TSTRIDE);
  for (int i = lane; i < 480; i += 64) { const int dr = i >> 5, dc = i & 31; tab[i] = (dc < 31) ? rpb[(h * 15 + dr) * 31 + dc] * 1.4426950408889634f : 0.f; }
  asm volatile("s_waitcnt lgkmcnt(0)" ::: "memory");
  const bf16x8 ones = {0x3f80, 0x3f80, 0x3f80, 0x3f80, 0x3f80, 0x3f80, 0x3f80, 0x3f80};
  const int vb0 = (int)(uintptr_t)Vw + v_rd_base(lane);
  int vgo[8], vso[8];
#pragma unroll
  for (int i = 0; i < 8; ++i) { const int p = i * 64 + lane, key = p >> 3, c8 = (p & 7) * 8; vgo[i] = key * LD + c8; vso[i] = v_st<2>(key, c8); }
  const int kgo0 = r32 * LD + hi * 8, kgo1 = (32 + r32) * LD + hi * 8;
  for (int wu = gw; wu < 20480; wu += NGW) {
    const int hf = (wu >> 3) & 1, rowg = wu >> 4;
    int base, r, rows;
    if (rowg < 256) { base = 0; r = rowg; rows = 256; } else { const int l = rowg - 256; base = 16384 + (l >> 6) * 4096; r = l & 63; rows = 64; }
    NaCtx c; c.s0q = min(max(r - 4, 0), rows - 8); c.klo = c.s0q; c.rq = r; c.qc = 32 * hf + r32; c.wstart = min(max(c.qc - 8, 0), 48); c.tab = tab;
    const long qrow = (long)base + r * 64 + hf * 32;
    const bf16_t* Qlane = QA + (qrow + r32) * LD + h * 64 + hi * 8;
    const bf16_t* Kb = QA + ((long)base + c.klo * 64) * LD + 512 + h * 64;
    const bf16_t* Vb = QA + ((long)base + c.klo * 64) * LD + 1024 + h * 64;
    bf16x8 qr[4];
#pragma unroll
    for (int d0 = 0; d0 < 4; ++d0) qr[d0] = *reinterpret_cast<const bf16x8*>(Qlane + d0 * 16);
    float m_ref = 0.f; f32x16 osum = f32x16{}, negm = f32x16{}, o[2]; o[0] = f32x16{}; o[1] = f32x16{};
    bf16x8 kf[8], vN[8];
#define KLOAD(t) do { _Pragma("unroll") for (int d0 = 0; d0 < 4; ++d0) { kf[2 * d0] = *reinterpret_cast<const bf16x8*>(Kb + (long)(t) * 64 * LD + kgo0 + d0 * 16); \
                                                                        kf[2 * d0 + 1] = *reinterpret_cast<const bf16x8*>(Kb + (long)(t) * 64 * LD + kgo1 + d0 * 16); } } while (0)
#define VLOAD(t) do { _Pragma("unroll") for (int i = 0; i < 8; ++i) vN[i] = *reinterpret_cast<const bf16x8*>(Vb + (long)(t) * 64 * LD + vgo[i]); } while (0)
#define VWRITE(b) do { _Pragma("unroll") for (int i = 0; i < 8; ++i) *(ALAS bf16x8*)(Vw + (b) * 8192 + vso[i]) = vN[i]; } while (0)
    KLOAD(0); VLOAD(0); VWRITE(0);
#pragma unroll
    for (int t = 0; t < 8; ++t) {
      const int b = t & 1;
      if (t + 1 < 8) VLOAD(t + 1);
      f32x16 p0, p1;
      qkt(p0, p1, kf, qr, negm);
      if (t + 1 < 8) { asm volatile("" ::: "memory"); KLOAD(t + 1); }
      na_bias(p0, p1, t, hi, c);
      float pmax = fmaxf(p0[0], p1[0]), pmx2 = fmaxf(p0[1], p1[1]);
#pragma unroll
      for (int q = 2; q < 16; q += 2) { pmax = __builtin_fmaxf(__builtin_fmaxf(pmax, p0[q]), p1[q]); pmx2 = __builtin_fmaxf(__builtin_fmaxf(pmx2, p0[q + 1]), p1[q + 1]); }
      pmax = fmaxf(pmax, pmx2);
      { auto rr = __builtin_amdgcn_permlane32_swap(__float_as_uint(pmax), __float_as_uint(pmax), false, false); pmax = fmaxf(__uint_as_float(rr[0]), __uint_as_float(rr[1])); }
      if (__builtin_expect(!__all(pmax <= THR2), 0)) {
        const float dl = fmaxf(pmax, 0.f); m_ref += dl;
#pragma unroll
        for (int q = 0; q < 16; ++q) { p0[q] -= dl; p1[q] -= dl; negm[q] = -m_ref; }
        const float f = __builtin_amdgcn_exp2f(-dl);
#pragma unroll
        for (int q = 0; q < 16; ++q) { const float ar = __shfl(f, crow(q, hi), 64); osum[q] *= ar; o[0][q] *= ar; o[1][q] *= ar; }
      }
#pragma unroll
      for (int q = 0; q < 16; ++q) { p0[q] = __builtin_amdgcn_exp2f(p0[q]); p1[q] = __builtin_amdgcn_exp2f(p1[q]); }
      bf16x8 pa0, pa1, pa2, pa3;
#define PK4(P, BASE, OUT) do { unsigned a0 = cvtpk(P[BASE + 0], P[BASE + 1]), a1 = cvtpk(P[BASE + 2], P[BASE + 3]);   \
    unsigned b0 = cvtpk(P[BASE + 4], P[BASE + 5]), b1 = cvtpk(P[BASE + 6], P[BASE + 7]);                              \
    auto r0 = __builtin_amdgcn_permlane32_swap(a0, b0, false, false); auto r1 = __builtin_amdgcn_permlane32_swap(a1, b1, false, false); \
    u32x4 w = {r0[0], r1[0], r0[1], r1[1]}; OUT = *reinterpret_cast<bf16x8*>(&w); } while (0)
      PK4(p0, 0, pa0); PK4(p0, 8, pa1); PK4(p1, 0, pa2); PK4(p1, 8, pa3);
#undef PK4
      { const int vb = vb0 + b * 8192; s16x4 LA[8], LB[8];
        v_issue_k<2, 0>(LA, vb); v_issue_k<2, 1>(LB, vb); asm volatile("s_waitcnt lgkmcnt(4)" ::: "memory"); SBAR(); v_mma_k<2>(o, osum, LA, pa0, ones); SBAR();
        v_issue_k<2, 2>(LA, vb); asm volatile("s_waitcnt lgkmcnt(4)" ::: "memory"); SBAR(); v_mma_k<2>(o, osum, LB, pa1, ones); SBAR();
        v_issue_k<2, 3>(LB, vb); asm volatile("s_waitcnt lgkmcnt(4)" ::: "memory"); SBAR(); v_mma_k<2>(o, osum, LA, pa2, ones); SBAR();
        asm volatile("s_waitcnt lgkmcnt(0)" ::: "memory"); SBAR(); v_mma_k<2>(o, osum, LB, pa3, ones); }
      if (t + 1 < 8) VWRITE(b ^ 1);
    }
#undef KLOAD
#undef VLOAD
#undef VWRITE
    bf16_t* Ow = AB + qrow * 1024 + h * 64 + r32;
#pragma unroll
    for (int q = 0; q < 16; ++q) { const float rl = __builtin_amdgcn_rcpf(osum[q]); const int orow = crow(q, hi);
      Ow[(long)orow * 1024] = to_bf16(o[0][q] * rl); Ow[(long)orow * 1024 + 32] = to_bf16(o[1][q] * rl); }
    asm volatile("s_waitcnt lgkmcnt(0)" ::: "memory");
  }
}
__device__ __forceinline__ void diff_unit(int base, int seq, int h, int qblk, const bf16_t* QB, bf16_t* AB, float lam, float one_m_li, const float* subln, ALAS char* lds) {
  int tid_ = threadIdx.x; asm volatile("" : "+v"(tid_));
  const int tid = tid_, wid = __builtin_amdgcn_readfirstlane(tid >> 6), lane = tid & 63, r32 = lane & 31, hi = lane >> 5;
  const int row0 = base + qblk * 256;
  ALAS unsigned* stash = (ALAS unsigned*)(lds + L_STASH) + wid * 2048;
  NaCtx c{};
  f32x16 o[4];
  for (int mp = 0; mp < 2; ++mp) {
    const bf16_t* Qlane = QB + (long)(row0 + wid * 32 + r32) * LD + h * 128 + mp * 64 + hi * 8;
    const bf16_t* Kh = QB + (long)base * LD + 512 + h * 128 + mp * 64;
    const bf16_t* Vh = QB + (long)base * LD + 1024 + h * 128;
    attn_core<128, false>(Qlane, Kh, Vh, seq >> 6, lds, o, c);
    if (mp == 0) {
#pragma unroll
      for (int d0 = 0; d0 < 4; ++d0)
#pragma unroll
        for (int r = 0; r < 16; r += 2) stash[(d0 * 8 + (r >> 1)) * 64 + lane] = cvtpk(o[d0][r], o[d0][r + 1]);
    }
  }
  asm volatile("s_waitcnt lgkmcnt(0)" ::: "memory");
  float sg[4];
#pragma unroll
  for (int d0 = 0; d0 < 4; ++d0) sg[d0] = subln[d0 * 32 + r32] * one_m_li;
  bf16_t* Ow = AB + (long)(row0 + wid * 32) * 1024 + 512 + h * 128 + r32;
#pragma unroll
  for (int r = 0; r < 16; r += 2) {
    float v0[4], v1[4]; float s0 = 0.f, s1 = 0.f;
#pragma unroll
    for (int d0 = 0; d0 < 4; ++d0) { const unsigned w = stash[(d0 * 8 + (r >> 1)) * 64 + lane];
      v0[d0] = __uint_as_float(w << 16) - lam * o[d0][r]; v1[d0] = __uint_as_float(w & 0xffff0000u) - lam * o[d0][r + 1];
      s0 += v0[d0] * v0[d0]; s1 += v1[d0] * v1[d0]; }
#pragma unroll
    for (int x = 1; x < 32; x <<= 1) { s0 += __shfl_xor(s0, x); s1 += __shfl_xor(s1, x); }
    const float rs0 = 1.0f / sqrtf(s0 * (1.0f / 128.0f) + 1e-5f), rs1 = 1.0f / sqrtf(s1 * (1.0f / 128.0f) + 1e-5f);
    const int or0 = crow(r, hi), or1 = crow(r + 1, hi);
#pragma unroll
    for (int d0 = 0; d0 < 4; ++d0) { Ow[(long)or0 * 1024 + d0 * 32] = to_bf16(v0[d0] * rs0 * sg[d0]); Ow[(long)or1 * 1024 + d0 * 32] = to_bf16(v1[d0] * rs1 * sg[d0]); }
  }
}
#undef SBAR
}
#define LAS __attribute__((address_space(3)))
typedef unsigned short bf16;
typedef unsigned v4u __attribute__((ext_vector_type(4)));
typedef unsigned v2u __attribute__((ext_vector_type(2)));
typedef float f32x4 __attribute__((ext_vector_type(4)));
constexpr int NWAVES = 8;
constexpr int MTOK = 81920, NP = 16384, DM = 1024, DFF = 2816, NLAYER = 2;
constexpr size_t MiB = 1u << 20;
constexpr size_t WS_GNH = 64 * 1024;
constexpr size_t WS_RPB = 128 * 1024, WS_SUB = 192 * 1024, WS_LAM = 200 * 1024;
constexpr size_t WS_ROPE = 1 * MiB;
constexpr size_t WS_W = 4 * MiB, WS_WL = 48 * MiB;
constexpr size_t WS_H = 104 * MiB;
constexpr size_t WS_R = 264 * MiB;
constexpr size_t WS_T = WS_R;
constexpr size_t WS_QA = WS_R, WS_QB = WS_R + 240 * MiB, WS_AB = WS_R + 480 * MiB;
constexpr size_t WS_G = WS_R, WS_MG = WS_R + 320 * MiB;
constexpr size_t WS_SS = WS_R + 640 * MiB;
constexpr size_t WS_END = WS_SS + 6 * MiB;
constexpr size_t WO_WI1 = 0, WO_WO1 = WO_WI1 + (size_t)5632 * 1024, WO_QKV = WO_WO1 + (size_t)1024 * 2816, WO_G = WO_QKV + (size_t)3072 * 1024,
                 WO_AB = WO_G + (size_t)2048 * 1024, WO_OUT = WO_AB + (size_t)1024 * 1024, WO_WI2 = WO_OUT + (size_t)1024 * 1024, WO_WO2 = WO_WI2 + (size_t)5632 * 1024,
                 WO_END = WO_WO2 + (size_t)1024 * 2816;
static_assert(WO_END * 2 <= WS_WL, "weight block");
constexpr int RING_BYTES = 131072, LDS_BYTES = 147456;
static_assert(att::L_END <= LDS_BYTES && att::NAW_END <= LDS_BYTES - 64, "attention LDS");

#define LDS_WAIT() asm volatile("s_waitcnt lgkmcnt(0)" ::: "memory")
__device__ __forceinline__ unsigned f2bf(float f) { unsigned u = __builtin_bit_cast(unsigned, f); return (u + 0x7fffu + ((u >> 16) & 1u)) >> 16; }
__device__ __forceinline__ unsigned pk2(float lo, float hi) { return f2bf(lo) | (f2bf(hi) << 16); }
__device__ __forceinline__ float wave_sum(float v) {
#pragma unroll
    for (int o = 1; o < 64; o <<= 1) v += __shfl_xor(v, o);
    return v;
}
__device__ __forceinline__ void tr_item(const float* W, int N, int k0, int n0, bf16* dst, int drow0, int ldd, int koff, LAS float* scr, int lane, const float* g = nullptr) {
    {   const int kr = lane >> 3, c4 = (lane & 7) * 4;
        f32x4 wv[8];
#pragma unroll
        for (int i = 0; i < 8; ++i) wv[i] = *(const f32x4*)(W + (size_t)(k0 + i * 8 + kr) * N + n0 + c4);
#pragma unroll
        for (int i = 0; i < 8; ++i) { const int kk = i * 8 + kr; const float gk = g ? g[k0 + kk] : 1.0f; LAS float* d = scr + kk * 33 + c4;
            d[0] = wv[i][0] * gk; d[1] = wv[i][1] * gk; d[2] = wv[i][2] * gk; d[3] = wv[i][3] * gk; } }
    LDS_WAIT(); asm volatile("" ::: "memory");
    const int c = lane & 7;
#pragma unroll
    for (int j = 0; j < 4; ++j) { const int n = (lane >> 3) + 8 * j; const LAS float* s = scr + (8 * c) * 33 + n;
        v4u o; o.x = pk2(s[0 * 33], s[1 * 33]); o.y = pk2(s[2 * 33], s[3 * 33]); o.z = pk2(s[4 * 33], s[5 * 33]); o.w = pk2(s[6 * 33], s[7 * 33]);
        *(v4u*)(dst + (size_t)(drow0 + n) * ldd + koff + k0 + 8 * c) = o; }
    LDS_WAIT(); asm volatile("" ::: "memory");
}
__device__ __forceinline__ void xb_row(const float* xrow, bf16* orow, float* ssrow, int lane) {
    const f32x4* xr = (const f32x4*)xrow + lane;
    f32x4 v[4]; float s = 0.f;
#pragma unroll
    for (int j = 0; j < 4; ++j) { v[j] = xr[64 * j]; s += (v[j].x * v[j].x + v[j].y * v[j].y) + (v[j].z * v[j].z + v[j].w * v[j].w); }
    s = wave_sum(s);
    v2u* o8 = (v2u*)orow + lane;
#pragma unroll
    for (int j = 0; j < 4; ++j) { v2u w; w.x = pk2(v[j].x, v[j].y); w.y = pk2(v[j].z, v[j].w); o8[64 * j] = w; }
    if (lane < 16) ssrow[lane] = (lane == 0) ? s : 0.f;
}

constexpr size_t WS_BAR = 256 * 1024;
#define RLX_AGENT __ATOMIC_RELAXED, __HIP_MEMORY_SCOPE_AGENT
#define XB_TMO      128
#define XB_XCNT(j)  (256  + 64 * (j))
#define XB_XSUB(j)  (1280 + 64 * (j))
#define XB_XGEN(j)  (2304 + 64 * (j))
#define XB_TOP      3328
#define XB_TOPGEN   3392
#define XCD_BAR_WORDS 3456
#define XB_SPIN_CAP (1u << 18)

__device__ __forceinline__ unsigned xb_ld(unsigned* p)              { return __hip_atomic_load(p, __ATOMIC_RELAXED, __HIP_MEMORY_SCOPE_AGENT); }
__device__ __forceinline__ unsigned xb_add(unsigned* p, unsigned v) { return __hip_atomic_fetch_add(p, v, __ATOMIC_RELAXED, __HIP_MEMORY_SCOPE_AGENT); }
__device__ __forceinline__ unsigned xb_xcc_id() { return (unsigned)__builtin_amdgcn_s_getreg((3 << 11) | 20) & 0xFu; }
#define XB_SPIN(cond, bar) do { unsigned _sp = 0; while (cond) { __builtin_amdgcn_s_sleep(1); \
    if ((++_sp & 255u) == 0u) { if (xb_ld(&(bar)[XB_TMO])) break; if (_sp > XB_SPIN_CAP) { atomicAdd(&(bar)[XB_TMO], 1u); break; } } } } while (0)

struct XcdBarrier {
    unsigned* bar; unsigned x;
    volatile LAS unsigned* st;
};

__device__ __forceinline__ XcdBarrier xcd_barrier_post(unsigned* bar, volatile LAS unsigned* st) {
    XcdBarrier b; b.bar = bar; b.x = xb_xcc_id(); b.st = st;
    if (threadIdx.x == 0) (void)xb_add(&bar[XB_XCNT(b.x)], 1u);
    return b;
}
__device__ __forceinline__ void xcd_barrier_complete(unsigned* bar, unsigned x, unsigned& nloc, unsigned& nx) {
    const unsigned G = gridDim.x * gridDim.y * gridDim.z;
    unsigned sum, cnt, mine, sp = 0u;
    for (;;) {
        sum = 0u; cnt = 0u; mine = 0u;
#pragma unroll
        for (unsigned j = 0; j < 16; ++j) { const unsigned c = xb_ld(&bar[XB_XCNT(j)]); sum += c; cnt += (c > 0u) ? 1u : 0u; mine = (j == x) ? c : mine; }
        if (sum == G) break;
        __builtin_amdgcn_s_sleep(1);
        if ((++sp & 255u) == 0u) { if (xb_ld(&bar[XB_TMO])) break; if (sp > XB_SPIN_CAP) { atomicAdd(&bar[XB_TMO], 1u); break; } }
    }
    nloc = mine > 0u ? mine : 1u; nx = cnt > 0u ? cnt : 1u;
}

__device__ __forceinline__ void xcd_barrier(const XcdBarrier& b) {
    asm volatile("s_waitcnt vmcnt(0)" ::: "memory");
    __syncthreads();
    if (threadIdx.x == 0) {
        unsigned* bar = b.bar;
        __builtin_amdgcn_s_waitcnt(0);
        unsigned nloc = b.st[0], nx = b.st[1];
        if (nloc == 0u) { xcd_barrier_complete(bar, b.x, nloc, nx); b.st[0] = nloc; b.st[1] = nx; }
        const unsigned old = xb_add(&bar[XB_XSUB(b.x)], 1u);
        const unsigned gen = old / nloc;
        if (old + 1u == (gen + 1u) * nloc) {
            __builtin_amdgcn_fence(__ATOMIC_RELEASE, "agent");
            asm volatile("s_waitcnt vmcnt(0)" ::: "memory");
            const unsigned og = xb_add(&bar[XB_TOP], 1u);
            const unsigned tg = og / nx;
            if (og + 1u == (tg + 1u) * nx) xb_add(&bar[XB_TOPGEN], 1u);
            else XB_SPIN(xb_ld(&bar[XB_TOPGEN]) == tg, bar);
            __builtin_amdgcn_fence(__ATOMIC_ACQUIRE, "agent");
            xb_add(&bar[XB_XGEN(b.x)], 1u);
            asm volatile("s_waitcnt vmcnt(0)" ::: "memory");
        } else {
            XB_SPIN(xb_ld(&bar[XB_XGEN(b.x)]) == gen, bar);
            __builtin_amdgcn_fence(__ATOMIC_ACQUIRE, "agent");
            asm volatile("s_waitcnt vmcnt(0)" ::: "memory");
        }
    }
    __syncthreads();
}

#define GSYNC() xcd_barrier(xbar)
struct Args { const float* in[23]; float* out; unsigned char* ws; };

__global__ void __launch_bounds__(NWAVES * 64, 2) mega_fwd(Args a) {
    extern __shared__ __attribute__((aligned(16))) unsigned char lds_raw[];
    cg::grid_group grid = cg::this_grid();
    LAS unsigned char* lds = (LAS unsigned char*)lds_raw;
    const int tid = threadIdx.x, lane = tid & 63, wave = __builtin_amdgcn_readfirstlane(tid >> 6);
    const int G = gridDim.x, bx = blockIdx.x;
    const int vcu = (G % 8 == 0) ? (bx % 8) * (G / 8) + bx / 8 : bx;
    const int gw = vcu * NWAVES + wave, NGW = G * NWAVES;
    unsigned char* ws = a.ws;
    volatile LAS unsigned* xb_st = (volatile LAS unsigned*)(lds + LDS_BYTES - 64);
    if (tid < 2) xb_st[tid] = 0u;
    __syncthreads();
    const XcdBarrier xbar = xcd_barrier_post((unsigned*)(ws + WS_BAR), xb_st);
    float* xbuf = a.out;
    bf16* Hb = (bf16*)(ws + WS_H); bf16* Tb = (bf16*)(ws + WS_T); bf16* QAb = (bf16*)(ws + WS_QA); bf16* QBb = (bf16*)(ws + WS_QB);
    bf16* ABb = (bf16*)(ws + WS_AB); bf16* Gb = (bf16*)(ws + WS_G); bf16* MGb = (bf16*)(ws + WS_MG); float* rope = (float*)(ws + WS_ROPE); float* SSb = (float*)(ws + WS_SS); float* gnh = (float*)(ws + WS_GNH); float* rpbw = (float*)(ws + WS_RPB); float* subw = (float*)(ws + WS_SUB); float* lamw = (float*)(ws + WS_LAM);

    {
        LAS float* scr = (LAS float*)(lds + wave * 16384);
        constexpr int I0 = 16 * 176, I1 = 44 * 32, I2 = 16 * 160, I3 = 8 * 32, I4 = 8 * 32, I5 = 16 * 32, I6 = I0, I7 = I1;
        constexpr int NI = I0 + I1 + I2 + I3 + I4 + I5 + I6 + I7;
        for (int it = gw; it < NLAYER * NI; it += NGW) {
            const int l = it / NI; int r = it % NI;
            bf16* wl = (bf16*)(ws + WS_W + (size_t)l * WS_WL);
            if (r < I0 || (r >= I0 + I1 + I2 + I3 + I4 + I5 && r < NI - I7)) {
                const bool second = r >= I0; if (second) r -= I0 + I1 + I2 + I3 + I4 + I5;
                const float* W = a.in[second ? 21 : 3] + (size_t)l * 1024 * 5632;
                const int kb = r / 176, nb = r % 176, n0 = nb * 32; const int bj = n0 >= 2816, j = n0 - bj * 2816;
                tr_item(W, 5632, kb * 64, n0, wl + (second ? WO_WI2 : WO_WI1), 256 * (j >> 7) + 128 * bj + (j & 127), 1024, 0, scr, lane, a.in[second ? 20 : 2] + (size_t)l * DM);
                continue;
            }
            if (r >= NI - I7) { r -= NI - I7; const float* W = a.in[22] + (size_t)l * 2816 * 1024; const int kb = r / 32, nb = r % 32;
                tr_item(W, 1024, kb * 64, nb * 32, wl + WO_WO2, nb * 32, 2816, 0, scr, lane); continue; }
            r -= I0;
            if (r < I1) { const float* W = a.in[4] + (size_t)l * 2816 * 1024; const int kb = r / 32, nb = r % 32;
                tr_item(W, 1024, kb * 64, nb * 32, wl + WO_WO1, nb * 32, 2816, 0, scr, lane); continue; }
            r -= I1;
            if (r < I2) { const float* W = a.in[6] + (size_t)l * 1024 * 5120; const int kb = r / 160, nb = r % 160, n0 = nb * 32;
                if (n0 < 3072) { const int blk = n0 >> 8, o = n0 & 255, hh = o >> 6, bb = (o & 63) >> 5;
                    tr_item(W, 5120, kb * 64, n0, wl + WO_QKV, blk * 256 + 128 * bb + 32 * hh, 1024, 0, scr, lane, a.in[5] + (size_t)l * DM); }
                else { const int np = n0 - 3072, pb = np >= 1024, j = np - pb * 1024;
                    tr_item(W, 5120, kb * 64, n0, wl + WO_G, 256 * (j >> 7) + 128 * pb + (j & 127), 1024, 0, scr, lane, a.in[5] + (size_t)l * DM); }
                continue; }
            r -= I2;
            if (r < I3) { const float* W = a.in[17] + (size_t)l * 512 * 1024; const int kb = r / 32, nb = r % 32;
                tr_item(W, 1024, kb * 64, nb * 32, wl + WO_AB, nb * 32, 512, 0, scr, lane); continue; }
            r -= I3;
            if (r < I4) { const float* W = a.in[18] + (size_t)l * 512 * 1024; const int kb = r / 32, nb = r % 32;
                tr_item(W, 1024, kb * 64, nb * 32, wl + WO_AB, 1024 + nb * 32, 512, 0, scr, lane); continue; }
            r -= I4;
            { const float* W = a.in[19] + (size_t)l * 1024 * 1024; const int kb = r / 32, nb = r % 32;
                tr_item(W, 1024, kb * 64, nb * 32, wl + WO_OUT, nb * 32, 1024, 0, scr, lane); }
        }
        for (int mrow = gw; mrow < MTOK; mrow += NGW)
            xb_row(mrow < NP ? a.in[0] + (size_t)mrow * DM : a.in[1] + (size_t)(mrow - NP) * DM, Hb + (size_t)mrow * DM, SSb + (size_t)mrow * 16, lane);
        for (int idx = (vcu * NWAVES * 64 + tid); idx < NLAYER * 6 * 64; idx += G * NWAVES * 64) {
            const int l = idx / 384, p = (idx / 64) % 6, c = idx % 64;
            gnh[idx] = (p == 0) ? a.in[7][l * 64 + c] : (p == 1) ? a.in[8][l * 64 + c] : (p == 3) ? a.in[10][l * 64 + c] : (p == 4) ? a.in[11][l * 64 + c] : 1.0f;
        }
        for (int idx = (vcu * NWAVES * 64 + tid); idx < NLAYER * 3720; idx += G * NWAVES * 64) rpbw[idx] = a.in[9][idx];
        for (int idx = (vcu * NWAVES * 64 + tid); idx < NLAYER * 128; idx += G * NWAVES * 64) subw[idx] = a.in[16][idx];
        if (vcu == 0 && wave < NLAYER) { const int l = wave;
            const float s1 = wave_sum(a.in[12][l * 64 + lane] * a.in[13][l * 64 + lane]), s2 = wave_sum(a.in[14][l * 64 + lane] * a.in[15][l * 64 + lane]);
            if (lane == 0) lamw[l] = expf(s1) - expf(s2) + (0.8f - 0.6f * expf(-0.3f * (float)l)); }
        for (int idx = (vcu * NWAVES * 64 + tid); idx < NP * 8; idx += G * NWAVES * 64) {
            const int pos = idx >> 3, i = idx & 7;
            const float invf = (i == 0) ? 1.0f : (i == 1) ? 0.19392274474868576f : (i == 2) ? 0.03760603093086393f : (i == 3) ? 0.007292664737217109f :
                               (i == 4) ? 0.001414213562373095f : (i == 5) ? 0.0002742481756762073f : (i == 6) ? 5.318295896944988e-05f : 1.031338537721246e-05f;
            const float angf = (float)pos * invf;
            const double ang = (double)angf; const double k = __builtin_rint(ang * 0.15915494309189535); const double r = __builtin_fma(-k, 6.283185307179586, ang) - k * 2.4492935982947064e-16;
            const double x2 = r * r; double ts = 1.0, tc = 1.0, ss = 1.0, sc = 1.0;
#pragma unroll
            for (int q = 1; q <= 14; ++q) { tc = -tc * x2 * (1.0 / (double)((2 * q - 1) * (2 * q))); ts = -ts * x2 * (1.0 / (double)((2 * q) * (2 * q + 1))); sc += tc; ss += ts; }
            rope[pos * 16 + i] = (float)sc; rope[pos * 16 + 8 + i] = (float)(ss * r);
        }
    }
    GSYNC();
    grid.sync();

    float lam = 0.f, one_m_li = 1.f;
    for (int ph = 0; ph < NLAYER * 9; ++ph) {
        const int l = ph / 9, k = ph % 9;
        const bf16* wl = (const bf16*)(ws + WS_W + (size_t)l * WS_WL);
        const bool first_x = (ph == 1);
        if (k == 0 || k == 7) {
            pg8::Gemm g{Hb, wl + (k == 0 ? WO_WI1 : WO_WI2), MTOK, 5632, 1024}; pg8::StaticOrder S; S.init(MTOK, 5632, G, bx, ph & 1);
            pg8::EpiSwiglu E{Tb, SSb};
            pg8::gemm_phase<pg8::EpiSwiglu, pg8::StaticOrder, true, true>(lds, g, S, E);
        } else if (k == 1 || k == 6 || k == 8) {
            pg8::Gemm g{k == 6 ? MGb : Tb, wl + (k == 1 ? WO_WO1 : k == 6 ? WO_OUT : WO_WO2), MTOK, 1024, k == 6 ? 1024 : 2816}; pg8::StaticOrder S; S.init(MTOK, 1024, G, bx, ph & 1);
            pg8::EpiResid E{xbuf, k == 6 ? 1.0f : 0.5f, Hb, SSb, (ph == NLAYER * 9 - 1) ? 1 : 0};
            pg8::gemm_phase<pg8::EpiResid, pg8::StaticOrder, true, true>(lds, g, S, E);
        } else if (k == 2) {
            pg8::Gemm g{Hb, wl + WO_QKV, MTOK, 3072, 1024}; pg8::StaticOrder S; S.init(MTOK, 3072, G, bx, ph & 1);
            pg8::EpiQKV E{QAb, QBb, gnh + l * 384, rope, SSb};
            pg8::gemm_phase<pg8::EpiQKV, pg8::StaticOrder, true, true>(lds, g, S, E);
        } else if (k == 3) {
            const float li = 0.8f - 0.6f * expf(-0.3f * (float)l);
            lam = lamw[l]; one_m_li = 1.0f - li;
            const float* subln = subw + l * 128;
            for (int u = vcu; u < 256 + 1024; u += G) {
                if (u < 256) att::diff_unit(0, NP, u >> 6, u & 63, QBb, ABb, lam, one_m_li, subln, (LAS char*)lds);
                else { const int v = u - 256; att::diff_unit(NP + (v >> 6) * 4096, 4096, (v >> 4) & 3, v & 15, QBb, ABb, lam, one_m_li, subln, (LAS char*)lds); }
            }
            const float* rpb = rpbw + (size_t)l * 8 * 15 * 31;
            __syncthreads();
            att::na_wave_units(gw, NGW, QAb, ABb, rpb, (LAS char*)lds);
        } else if (k == 4) {
            pg8::Gemm g{ABb, wl + WO_AB, MTOK, 2048, 512, 1024, 1024}; pg8::StaticOrder S; S.init(MTOK, 2048, G, bx, ph & 1);
            pg8::EpiY E{Gb};
            pg8::gemm_phase<pg8::EpiY, pg8::StaticOrder, true, true>(lds, g, S, E);
        } else {
            pg8::Gemm g{Hb, wl + WO_G, MTOK, 2048, 1024}; pg8::StaticOrder S; S.init(MTOK, 2048, G, bx, ph & 1);
            pg8::EpiGateMerge E{Gb, MGb, SSb};
            pg8::gemm_phase<pg8::EpiGateMerge, pg8::StaticOrder, true, true>(lds, g, S, E);
        }
        if (ph != NLAYER * 9 - 1) GSYNC();
    }
}

extern "C" void kernel_launch(void* const* d_in, const int* in_sizes, int n_in, void* d_out, int out_size, void* d_ws, size_t ws_size, hipStream_t stream) {
    static int grid = 0;
    if (grid == 0) {
        if (n_in != 23 || out_size != MTOK * DM || ws_size < WS_END) { fprintf(stderr, "kernel_launch: unexpected shapes: n_in %d out %d ws %zu (need >= %zu)\n", n_in, out_size, ws_size, (size_t)WS_END); grid = -1; return; }
        int dev = 0, cus = 0, per_cu = 0;
        (void)hipGetDevice(&dev); (void)hipDeviceGetAttribute(&cus, hipDeviceAttributeMultiprocessorCount, dev);
        if (hipFuncSetAttribute((const void*)mega_fwd, hipFuncAttributeMaxDynamicSharedMemorySize, LDS_BYTES) != hipSuccess) { fprintf(stderr, "kernel_launch: hipFuncSetAttribute failed\n"); grid = -1; return; }
        if (hipOccupancyMaxActiveBlocksPerMultiprocessor(&per_cu, (const void*)mega_fwd, NWAVES * 64, LDS_BYTES) != hipSuccess || per_cu < 1) { fprintf(stderr, "kernel_launch: occupancy query says %d\n", per_cu); per_cu = 1; }
        (void)hipGetLastError();
        grid = cus * per_cu;
        fprintf(stderr, "kernel_launch: grid %d (cus %d x %d)\n", grid, cus, per_cu);
    }
    if (grid < 0) return;
    if (hipMemsetAsync((char*)d_ws + WS_BAR, 0, 16384, stream) != hipSuccess) { fprintf(stderr, "kernel_launch: memset failed\n"); return; }
    Args a{};
    for (int i = 0; i < 23; ++i) a.in[i] = (const float*)d_in[i];
    a.out = (float*)d_out; a.ws = (unsigned char*)d_ws;
    void* args[] = {&a};
    const hipError_t e = hipLaunchCooperativeKernel((const void*)mega_fwd, dim3(grid), dim3(NWAVES * 64), args, LDS_BYTES, stream);
    if (e != hipSuccess) fprintf(stderr, "kernel_launch: cooperative launch failed: %s (grid %d)\n", hipGetErrorString(e), grid);
}
```

```cpp
#include <hip/hip_runtime.h>
#include <hip/hip_cooperative_groups.h>
#include <cstdio>
#include <cstdint>
namespace cg = cooperative_groups;
namespace pg8 {
#define PG8_LAS __attribute__((address_space(3)))
typedef unsigned short bf16_t;
typedef short bf16x8 __attribute__((ext_vector_type(8)));
typedef float f32x4 __attribute__((ext_vector_type(4)));
typedef unsigned u32x4 __attribute__((ext_vector_type(4)));
constexpr int BM = 256, BK = 64, HALF = 128, HTB = HALF * BK * 2  , STAGE_BYTES = 8 * HTB, NXCD = 8, WGM = 8;

__host__ __device__ __forceinline__ int lds_byte(int r, int c) { const int st = (r >> 4) * 2 + (c >> 5), rr = r & 15, cc = c & 31, ob = rr * 64 + cc * 2; return st * 1024 + (ob ^ (((ob >> 9) & 1) << 5)); }
__host__ __device__ __forceinline__ void stage_rc(int b, int& R, int& C) { const int st = b / 1024, sb = b % 1024, swz = sb ^ (((sb >> 9) & 1) << 5); R = (st >> 1) * 16 + swz / 64; C = (st & 1) * 32 + (swz % 64) / 2; }
__host__ __device__ __forceinline__ int perm32(int rho) { const int n = rho >> 4, i = rho & 15; return 8 * (i >> 2) + 4 * n + (i & 3); }

struct Unit { int pm, pn; };
struct Gemm { const bf16_t* A; const bf16_t* Bt; int M, N, K; int lda = 0, aselb = 0; };

struct StaticOrder {
    int nM, nN, nwg, G, c, nr, rev;
    __host__ __device__ void init(int M, int N, int G_, int c_, int rev_ = 0) { nM = M / BM; nN = N / BM; nwg = nM * nN; G = G_; c = c_; rev = rev_; nr = (c < nwg) ? (nwg - c + G - 1) / G : 0; }
    __host__ __device__ bool next(int i, Unit& u) const {
        if (i >= nr) return false;
        const long L = (long)(rev ? nr - 1 - i : i) * G + c;
        int wgid = (int)L; { const int q = nwg / NXCD, r = nwg % NXCD, xcd = wgid % NXCD, off = wgid / NXCD; wgid = (xcd < r ? xcd * (q + 1) : r * (q + 1) + (xcd - r) * q) + off; }
        const int nig = WGM * nN, gid = wgid / nig, fm = gid * WGM, gsz = (nM - fm) < WGM ? (nM - fm) : WGM;
        u.pm = fm + ((wgid % nig) % gsz); u.pn = (wgid % nig) / gsz; return true;
    }
    __device__ __forceinline__ void a_ready(const Unit&) const {}
    __device__ __forceinline__ void done(const Unit&) const {}
};

typedef float f32x2c_ __attribute__((ext_vector_type(2))); typedef __bf16 bf16x2c_ __attribute__((ext_vector_type(2)));
__device__ __forceinline__ unsigned cvt_pk_bf16(float lo, float hi) { f32x2c_ v = {lo, hi}; bf16x2c_ b = __builtin_convertvector(v, bf16x2c_); return __builtin_bit_cast(unsigned, b); }
typedef float f32x2 __attribute__((ext_vector_type(2)));
typedef unsigned u32x2 __attribute__((ext_vector_type(2)));
constexpr int DM_ = 1024, DFF_ = 2816, LDQKV_ = 1536, LDG_ = 2048;
constexpr float LOG2E_ = 1.4426950408889634f;
constexpr float QSCALE_ = 0.125f * 1.4426950408889634f;
__device__ __forceinline__ float sigm(float x) { return __builtin_amdgcn_rcpf(1.f + __builtin_amdgcn_exp2f(-LOG2E_ * x)); }
__device__ __forceinline__ float bf_lo(unsigned w) { return __uint_as_float(w << 16); }
__device__ __forceinline__ float bf_hi(unsigned w) { return __uint_as_float(w & 0xffff0000u); }
__device__ __forceinline__ u32x4 pack8(const f32x4 a, const f32x4 b) { u32x4 w; w.x = cvt_pk_bf16(a[0], a[1]); w.y = cvt_pk_bf16(a[2], a[3]); w.z = cvt_pk_bf16(b[0], b[1]); w.w = cvt_pk_bf16(b[2], b[3]); return w; }


__device__ __forceinline__ void row_rstd(const float* SS, int row0, int fq, float (&rs)[2][4]) {
    f32x4 pv[2][4];
#pragma unroll
    for (int ai = 0; ai < 2; ++ai)
#pragma unroll
        for (int m = 0; m < 4; ++m) pv[ai][m] = *(const f32x4*)(SS + (size_t)(row0 + ai * HALF + m * 16) * 16 + 4 * fq);
#pragma unroll
    for (int ai = 0; ai < 2; ++ai)
#pragma unroll
        for (int m = 0; m < 4; ++m) { float s = (pv[ai][m][0] + pv[ai][m][1]) + (pv[ai][m][2] + pv[ai][m][3]); s += __shfl_xor(s, 16); s += __shfl_xor(s, 32);
            rs[ai][m] = 1.0f / sqrtf(s * (1.0f / 1024.0f) + 1e-6f); }
}

struct EpiSwiglu {
    static constexpr bool PERM = true, AFTER_DRAIN = false, MID = false;
    bf16_t* T; const float* SS;
    __device__ __forceinline__ void operator()(const f32x4 (&acc)[2][2][4][2], const Unit& u, int wr, int wc, int fr, int fq) const {
        const int row0 = u.pm * BM + wr * 64 + fr, col0 = u.pn * 128 + wc * 32 + 8 * fq;
        float rs[2][4]; row_rstd(SS, row0, fq, rs);
#pragma unroll
        for (int ai = 0; ai < 2; ++ai)
#pragma unroll
            for (int m = 0; m < 4; ++m) {
                bf16_t* rowp = T + (size_t)(row0 + ai * HALF + m * 16) * DFF_ + col0;
                f32x4 v[2];
#pragma unroll
                for (int n = 0; n < 2; ++n)
#pragma unroll
                    for (int i = 0; i < 4; ++i) { const float a = acc[ai][0][m][n][i] * rs[ai][m], b = acc[ai][1][m][n][i] * rs[ai][m]; v[n][i] = a * sigm(a) * b; }
                *(u32x4*)rowp = pack8(v[0], v[1]);
            }
    }
};
struct EpiResid {
    static constexpr bool PERM = true, AFTER_DRAIN = false, MID = false;
    float* xout; float s; bf16_t* XB; float* SS; int final_;
    __device__ __forceinline__ void operator()(const f32x4 (&acc)[2][2][4][2], const Unit& u, int wr, int wc, int fr, int fq) const {
        const int col0 = u.pn * BM + wc * 32 + 8 * fq;
        u32x4 xall[2][4][2];
#pragma unroll
        for (int ai = 0; ai < 2; ++ai)
#pragma unroll
            for (int m = 0; m < 4; ++m)
#pragma unroll
                for (int bj = 0; bj < 2; ++bj) xall[ai][m][bj] = *(const u32x4*)(XB + (size_t)(u.pm * BM + ai * HALF + wr * 64 + m * 16 + fr) * DM_ + col0 + bj * HALF);
#pragma unroll
        for (int ai = 0; ai < 2; ++ai)
#pragma unroll
            for (int m = 0; m < 4; ++m) {
                const int row = u.pm * BM + ai * HALF + wr * 64 + m * 16 + fr;
                const size_t off = (size_t)row * DM_ + col0;
                u32x4 xb[2];
#pragma unroll
                for (int bj = 0; bj < 2; ++bj) xb[bj] = xall[ai][m][bj];
                float ss = 0.f;
#pragma unroll
                for (int bj = 0; bj < 2; ++bj) {
                    f32x4 xv[2];
#pragma unroll
                    for (int w = 0; w < 4; ++w) { xv[w >> 1][(w & 1) * 2] = bf_lo(xb[bj][w]) + acc[ai][bj][m][w >> 1][(w & 1) * 2] * s; xv[w >> 1][(w & 1) * 2 + 1] = bf_hi(xb[bj][w]) + acc[ai][bj][m][w >> 1][(w & 1) * 2 + 1] * s; }
                    if (final_) { *(f32x4*)(xout + off + bj * HALF) = xv[0]; *(f32x4*)(xout + off + bj * HALF + 4) = xv[1]; }
                    else {
#pragma unroll
                        for (int n = 0; n < 2; ++n) ss += (xv[n][0] * xv[n][0] + xv[n][1] * xv[n][1]) + (xv[n][2] * xv[n][2] + xv[n][3] * xv[n][3]);
                        *(u32x4*)(XB + off + bj * HALF) = pack8(xv[0], xv[1]);
                    }
                }
                if (!final_) { ss += __shfl_xor(ss, 16); ss += __shfl_xor(ss, 32); if (fq == 0) SS[(size_t)row * 16 + u.pn * 4 + wc] = ss; }
                asm volatile("" ::: "memory");
            }
    }
};
struct EpiQKV {
    static constexpr bool PERM = true, AFTER_DRAIN = false, MID = false;
    bf16_t* QA; bf16_t* QB; const float* gn; const float* rope; const float* SS;
    __device__ __forceinline__ void operator()(const f32x4 (&acc)[2][2][4][2], const Unit& u, int wr, int wc, int fr, int fq) const {
        const int part = u.pn >> 1, sub = u.pn & 1, p3 = part % 3;
        bf16_t* dst = (part < 3) ? QA : QB;
        const int pcol = p3 * 512 + sub * 256 + wc * 64 + 8 * fq;
        const bool isqk = (p3 != 2), isq = (p3 == 0), dorope = (part >= 3) && isqk;
        const float* g = gn + part * 64;
        f32x4 gv[2][2];
#pragma unroll
        for (int bj = 0; bj < 2; ++bj)
#pragma unroll
            for (int n = 0; n < 2; ++n) gv[bj][n] = *(const f32x4*)(g + 32 * bj + 8 * fq + 4 * n);
        float rsx[2][4]; row_rstd(SS, u.pm * BM + wr * 64 + fr, fq, rsx);
#pragma unroll
        for (int ai = 0; ai < 2; ++ai)
#pragma unroll
            for (int m = 0; m < 4; ++m) {
                const int row = u.pm * BM + ai * HALF + wr * 64 + m * 16 + fr;
                f32x4 v[2][2];
#pragma unroll
                for (int bj = 0; bj < 2; ++bj)
#pragma unroll
                    for (int n = 0; n < 2; ++n) v[bj][n] = acc[ai][bj][m][n] * rsx[ai][m];
                if (isqk) {
                    float ss = 0.f;
#pragma unroll
                    for (int bj = 0; bj < 2; ++bj)
#pragma unroll
                        for (int n = 0; n < 2; ++n) ss += (v[bj][n][0] * v[bj][n][0] + v[bj][n][1] * v[bj][n][1]) + (v[bj][n][2] * v[bj][n][2] + v[bj][n][3] * v[bj][n][3]);
                    ss += __shfl_xor(ss, 16); ss += __shfl_xor(ss, 32);
                    const float rs = 1.0f / sqrtf(ss * (1.0f / 64.0f) + 1e-6f);
#pragma unroll
                    for (int bj = 0; bj < 2; ++bj)
#pragma unroll
                        for (int n = 0; n < 2; ++n) v[bj][n] = v[bj][n] * rs * gv[bj][n];
                    if (dorope) {
                        const int pos = (row < 16384) ? row : ((row - 16384) & 4095);
                        const float* cs = rope + (size_t)pos * 16;
#pragma unroll
                        for (int n = 0; n < 2; ++n) {
                            const f32x4 c = *(const f32x4*)(cs + 4 * n), s = *(const f32x4*)(cs + 8 + 4 * n);
                            const f32x4 me = v[0][n]; f32x4 ot;
#pragma unroll
                            for (int i = 0; i < 4; ++i) ot[i] = __shfl_xor(me[i], 16);
                            const f32x4 r0 = me * c - ot * s, r1 = me * c + ot * s;
                            if (fq == 0) v[0][n] = r0; else if (fq == 1) v[0][n] = r1;
                        }
                    }
                    if (isq) {
#pragma unroll
                        for (int bj = 0; bj < 2; ++bj)
#pragma unroll
                            for (int n = 0; n < 2; ++n) v[bj][n] = v[bj][n] * QSCALE_;
                    }
                }
                bf16_t* rowp = dst + (size_t)row * LDQKV_ + pcol;
#pragma unroll
                for (int bj = 0; bj < 2; ++bj) *(u32x4*)(rowp + 32 * bj) = pack8(v[bj][0], v[bj][1]);
            }
    }
};
struct EpiY {
    static constexpr bool PERM = true, AFTER_DRAIN = false, MID = false;
    bf16_t* Y;
    __device__ __forceinline__ void operator()(const f32x4 (&acc)[2][2][4][2], const Unit& u, int wr, int wc, int fr, int fq) const {
        const int row0 = u.pm * BM + wr * 64 + fr, col0 = u.pn * BM + wc * 32 + 8 * fq;
#pragma unroll
        for (int ai = 0; ai < 2; ++ai)
#pragma unroll
            for (int m = 0; m < 4; ++m) {
                bf16_t* rowp = Y + (size_t)(row0 + ai * HALF + m * 16) * LDG_ + col0;
#pragma unroll
                for (int bj = 0; bj < 2; ++bj) *(u32x4*)(rowp + bj * HALF) = pack8(acc[ai][bj][m][0], acc[ai][bj][m][1]);
            }
    }
};
struct EpiGateMerge {
    static constexpr bool PERM = true, AFTER_DRAIN = false, MID = false;
    const bf16_t* Y; bf16_t* MG; const float* SS;
    __device__ __forceinline__ void operator()(const f32x4 (&acc)[2][2][4][2], const Unit& u, int wr, int wc, int fr, int fq) const {
        const int row0 = u.pm * BM + wr * 64 + fr, col0 = u.pn * 128 + wc * 32 + 8 * fq;
        float rs[2][4]; row_rstd(SS, row0, fq, rs);
#pragma unroll
        for (int ai = 0; ai < 2; ++ai) {
            u32x4 ya[4], yb[4];
#pragma unroll
            for (int m = 0; m < 4; ++m) { const bf16_t* yp = Y + (size_t)(row0 + ai * HALF + m * 16) * LDG_ + col0; ya[m] = *(const u32x4*)yp; yb[m] = *(const u32x4*)(yp + 1024); }
#pragma unroll
            for (int m = 0; m < 4; ++m) {
                f32x4 v[2];
#pragma unroll
                for (int w = 0; w < 4; ++w) {
                    const int n = w >> 1, i0 = (w & 1) * 2;
                    v[n][i0]     = sigm(acc[ai][0][m][n][i0]     * rs[ai][m]) * bf_lo(ya[m][w]) + sigm(acc[ai][1][m][n][i0]     * rs[ai][m]) * bf_lo(yb[m][w]);
                    v[n][i0 + 1] = sigm(acc[ai][0][m][n][i0 + 1] * rs[ai][m]) * bf_hi(ya[m][w]) + sigm(acc[ai][1][m][n][i0 + 1] * rs[ai][m]) * bf_hi(yb[m][w]);
                }
                *(u32x4*)(MG + (size_t)(row0 + ai * HALF + m * 16) * DM_ + col0) = pack8(v[0], v[1]);
            }
            asm volatile("" ::: "memory");
        }
    }
};
template <class Epi, class Sched, bool ALIGN_EPI = false, bool SP2 = false>
__device__ __forceinline__ void gemm_phase(PG8_LAS unsigned char* lds, const Gemm g, const Sched& S, const Epi& E) {
    int tid_ = threadIdx.x; asm volatile("" : "+v"(tid_));
    const int tid = tid_, wid = __builtin_amdgcn_readfirstlane(tid >> 6), lane = tid & 63, wr = wid >> 2, wc = wid & 3, fr = lane & 15, fq = lane >> 4;
    const int K = g.K, nt = K / BK, lda = g.lda ? g.lda : g.K;
    unsigned voffA[2], voffB[2];
#pragma unroll
    for (int i = 0; i < 2; ++i) { int R, C; stage_rc(tid * 16 + i * 8192, R, C); const int Rb = Epi::PERM ? ((R & ~31) + perm32(R & 31)) : R;
        voffA[i] = (unsigned)(R * lda + C) * 2u; voffB[i] = (unsigned)(Rb * K + C) * 2u; }
    const size_t kstep = (size_t)(BK * 2);
    const size_t hstep = (size_t)HALF * K * 2;
    const size_t tstep = 2 * hstep;
    const size_t hstepA = (size_t)HALF * lda * 2, tstepA = 2 * hstepA;
    const unsigned ldsw = (unsigned)wid * 1024u;
    const int aoff = lds_byte(wr * 64 + fr, fq * 8), boff = lds_byte(wc * 32 + fr, fq * 8);
#define PG8_SA(b, h) (((b) * 2 + (h)) * HTB)
#define PG8_SB(b, h) ((4 + (b) * 2 + (h)) * HTB)
#define PG8_STAGE(bufoff, gbase, voff) do { _Pragma("unroll") for (int _i = 0; _i < 2; ++_i) \
        __builtin_amdgcn_global_load_lds((const unsigned*)((const char*)(gbase) + (voff)[_i]), (PG8_LAS unsigned*)(lds + (bufoff) + ldsw + _i * 8192), 16, 0, 0); } while (0)
#define PG8_LDA(dst, b, h) do { _Pragma("unroll") for (int m = 0; m < 4; ++m) _Pragma("unroll") for (int k = 0; k < 2; ++k) dst[m][k] = *(const PG8_LAS bf16x8*)(lds + PG8_SA(b, h) + aoff + m * 2048 + k * 1024); } while (0)
#define PG8_LDB(dst, b, h) do { _Pragma("unroll") for (int n = 0; n < 2; ++n) _Pragma("unroll") for (int k = 0; k < 2; ++k) dst[n][k] = *(const PG8_LAS bf16x8*)(lds + PG8_SB(b, h) + boff + n * 2048 + k * 1024); } while (0)
#define PG8_MMA(ai, bj, At, Bt) do { __builtin_amdgcn_s_setprio(1); _Pragma("unroll") for (int m = 0; m < 4; ++m) _Pragma("unroll") for (int n = 0; n < 2; ++n) _Pragma("unroll") for (int k = 0; k < 2; ++k) \
        acc[ai][bj][m][n] = __builtin_amdgcn_mfma_f32_16x16x32_bf16(Bt[n][k], At[m][k], acc[ai][bj][m][n], 0, 0, 0); __builtin_amdgcn_s_setprio(0); } while (0)
#define PG8_WAIT_V(n) asm volatile("s_waitcnt vmcnt(" #n ")" ::: "memory")
#define PG8_WAIT_L(n) asm volatile("s_waitcnt lgkmcnt(" #n ")" ::: "memory")
#define PG8_BAR __builtin_amdgcn_s_barrier()
#define PG8_SCHED __builtin_amdgcn_sched_barrier(0)
    Unit cur, nxt; int ui = 0;
    if (!S.next(0, cur)) return;
    f32x4 acc[2][2][4][2];
#pragma unroll
    for (int a = 0; a < 2; ++a)
#pragma unroll
        for (int b = 0; b < 2; ++b)
#pragma unroll
            for (int m = 0; m < 4; ++m)
#pragma unroll
                for (int n = 0; n < 2; ++n) acc[a][b][m][n] = (f32x4){0.f, 0.f, 0.f, 0.f};
    bf16x8 At[4][2], B0[2][2], B1[2][2];
    const char* cA = (const char*)g.A + (size_t)cur.pm * tstepA + (size_t)(cur.pn >> 2) * g.aselb; const char* cB = (const char*)g.Bt + (size_t)cur.pn * tstep;
    S.a_ready(cur);
    if constexpr (SP2) {
        PG8_STAGE(PG8_SB(0, 0), cB, voffB); PG8_STAGE(PG8_SB(0, 1), cB + hstep, voffB); PG8_STAGE(PG8_SA(0, 0), cA, voffA); PG8_STAGE(PG8_SA(0, 1), cA + hstepA, voffA);
        if (wr == 1) PG8_BAR;
        PG8_WAIT_V(2); PG8_BAR;
        PG8_STAGE(PG8_SB(1, 0), cB + kstep, voffB); PG8_STAGE(PG8_SA(1, 0), cA + kstep, voffA); PG8_STAGE(PG8_SB(1, 1), cB + hstep + kstep, voffB);
        PG8_WAIT_V(6); PG8_BAR;
    } else {
        PG8_STAGE(PG8_SB(0, 0), cB, voffB); PG8_STAGE(PG8_SA(0, 0), cA, voffA); PG8_STAGE(PG8_SB(0, 1), cB + hstep, voffB); PG8_STAGE(PG8_SA(0, 1), cA + hstepA, voffA);
        if (wr == 1) PG8_BAR;
        PG8_WAIT_V(4); PG8_BAR;
        PG8_STAGE(PG8_SB(1, 0), cB + kstep, voffB); PG8_STAGE(PG8_SA(1, 0), cA + kstep, voffA); PG8_STAGE(PG8_SB(1, 1), cB + hstep + kstep, voffB);
        PG8_WAIT_V(6); PG8_BAR;
    }
    for (;;) {
        const bool has_next = S.next(ui + 1, nxt);
        const char* nA = has_next ? (const char*)g.A + (size_t)nxt.pm * tstepA + (size_t)(nxt.pn >> 2) * g.aselb : cA; const char* nB = has_next ? (const char*)g.Bt + (size_t)nxt.pn * tstep : cB;
        for (int t = 0; t < nt; t += 2) {
            if constexpr (Epi::MID) { if (t == (nt >> 1)) E.mid(acc, cur, wr, wc, fr, fq); }
            const bool last = (t == nt - 2);
            const char* a1 = cA + (size_t)(t + 1) * kstep;
            const char* a2 = last ? nA : cA + (size_t)(t + 2) * kstep; const char* b2 = last ? nB : cB + (size_t)(t + 2) * kstep;
            const char* a3 = a2 + kstep; const char* b3 = b2 + kstep;
            if (last && has_next) S.a_ready(nxt);
            if constexpr (SP2) {
            PG8_LDB(B0, 0, 0); PG8_LDB(B1, 0, 1); PG8_SCHED; PG8_LDA(At, 0, 0); PG8_STAGE(PG8_SA(1, 1), a1 + hstepA, voffA);
            PG8_WAIT_V(8); PG8_WAIT_L(0); PG8_BAR; PG8_MMA(0, 0, At, B0); PG8_MMA(0, 1, At, B1); PG8_BAR; PG8_SCHED;
            PG8_LDA(At, 0, 1); PG8_STAGE(PG8_SB(0, 0), b2, voffB); PG8_STAGE(PG8_SB(0, 1), b2 + hstep, voffB); PG8_STAGE(PG8_SA(0, 0), a2, voffA);
            PG8_WAIT_V(8); PG8_WAIT_L(0); PG8_BAR; PG8_MMA(1, 0, At, B0); PG8_MMA(1, 1, At, B1); PG8_BAR; PG8_SCHED;
            PG8_LDB(B0, 1, 0); PG8_LDB(B1, 1, 1); PG8_SCHED; PG8_LDA(At, 1, 0); PG8_STAGE(PG8_SA(0, 1), a2 + hstepA, voffA);
            PG8_WAIT_V(8); PG8_WAIT_L(0); PG8_BAR; PG8_MMA(0, 0, At, B0); PG8_MMA(0, 1, At, B1); PG8_BAR; PG8_SCHED;
            PG8_LDA(At, 1, 1); PG8_STAGE(PG8_SB(1, 0), b3, voffB); PG8_STAGE(PG8_SB(1, 1), b3 + hstep, voffB); PG8_STAGE(PG8_SA(1, 0), a3, voffA);
            PG8_WAIT_V(8); PG8_WAIT_L(0); PG8_BAR; PG8_MMA(1, 0, At, B0); PG8_MMA(1, 1, At, B1); PG8_BAR; PG8_SCHED;
            } else {
            PG8_LDB(B0, 0, 0); PG8_SCHED; PG8_LDA(At, 0, 0); PG8_STAGE(PG8_SA(1, 1), a1 + hstepA, voffA);
            PG8_WAIT_L(8); PG8_BAR; PG8_WAIT_L(0); PG8_MMA(0, 0, At, B0); PG8_BAR; PG8_SCHED;
            PG8_LDB(B1, 0, 1); PG8_STAGE(PG8_SB(0, 0), b2, voffB);
            PG8_BAR; PG8_WAIT_L(0); PG8_MMA(0, 1, At, B1); PG8_BAR;
            PG8_LDA(At, 0, 1); PG8_STAGE(PG8_SA(0, 0), a2, voffA);
            PG8_BAR; PG8_WAIT_L(0); PG8_MMA(1, 0, At, B0); PG8_BAR; PG8_SCHED;
            PG8_STAGE(PG8_SB(0, 1), b2 + hstep, voffB);
            PG8_WAIT_V(6); PG8_BAR; PG8_MMA(1, 1, At, B1); PG8_BAR;
            PG8_LDB(B0, 1, 0); PG8_SCHED; PG8_LDA(At, 1, 0); PG8_STAGE(PG8_SA(0, 1), a2 + hstepA, voffA);
            PG8_WAIT_L(8); PG8_BAR; PG8_WAIT_L(0); PG8_MMA(0, 0, At, B0); PG8_BAR; PG8_SCHED;
            PG8_LDB(B1, 1, 1); PG8_STAGE(PG8_SB(1, 0), b3, voffB);
            PG8_BAR; PG8_WAIT_L(0); PG8_MMA(0, 1, At, B1); PG8_BAR;
            PG8_LDA(At, 1, 1); PG8_STAGE(PG8_SA(1, 0), a3, voffA);
            PG8_BAR; PG8_WAIT_L(0); PG8_MMA(1, 0, At, B0); PG8_BAR; PG8_SCHED;
            PG8_STAGE(PG8_SB(1, 1), b3 + hstep, voffB);
            PG8_WAIT_V(6); PG8_BAR; PG8_MMA(1, 1, At, B1); PG8_BAR;
            }
        }
        if constexpr (ALIGN_EPI) { if (wr == 0) PG8_BAR; }
        if constexpr (!Epi::AFTER_DRAIN) { E(acc, cur, wr, wc, fr, fq); S.done(cur); }
        if (!has_next) break;
#pragma unroll
        for (int a = 0; a < 2; ++a)
#pragma unroll
            for (int b = 0; b < 2; ++b)
#pragma unroll
                for (int m = 0; m < 4; ++m)
#pragma unroll
                    for (int n = 0; n < 2; ++n) acc[a][b][m][n] = (f32x4){0.f, 0.f, 0.f, 0.f};
        cur = nxt; cA = nA; cB = nB; ++ui;
        if constexpr (ALIGN_EPI) { if (wr == 1) PG8_BAR; }
    }
    PG8_WAIT_V(0);
    if constexpr (!ALIGN_EPI) { if (wr == 0) PG8_BAR; }
    PG8_BAR;
    if constexpr (Epi::AFTER_DRAIN) { E.fused(acc, cur, wr, wc, fr, fq, lds, wid, lane); S.done(cur); }
#undef PG8_SA
#undef PG8_SB
#undef PG8_STAGE
#undef PG8_LDA
#undef PG8_LDB
#undef PG8_MMA
#undef PG8_WAIT_V
#undef PG8_WAIT_L
#undef PG8_BAR
#undef PG8_SCHED
}
}
namespace att {
#define ALAS __attribute__((address_space(3)))
typedef unsigned short bf16_t;
using bf16x8 = __attribute__((ext_vector_type(8))) short;
using s16x4  = __attribute__((ext_vector_type(4))) short;
using f32x16 = __attribute__((ext_vector_type(16))) float;
using u32x4  = __attribute__((ext_vector_type(4))) unsigned;
constexpr int LD = 1536;
constexpr int SHM_K = 8192, SHM_V = 16384;
constexpr int L_V = 0, L_K = 2 * SHM_V, L_WS = L_K + 2 * SHM_K, L_TAB = L_WS + 2048, L_STASH = L_TAB + 2048, L_END = L_STASH + 65536;
constexpr float THR2 = 8.f;
#define KSWZ(row, colB) ((row) * 128 + ((colB) ^ ((((row) >> 1) & 7) << 4)))
#define SBAR() __builtin_amdgcn_sched_barrier(0)
__device__ __forceinline__ int crow(int r, int hi) { return (r & 3) + 8 * (r >> 2) + 4 * hi; }
typedef float f32x2c_ __attribute__((ext_vector_type(2))); typedef __bf16 bf16x2c_ __attribute__((ext_vector_type(2)));
__device__ __forceinline__ unsigned cvtpk(float lo, float hi) { f32x2c_ v = {lo, hi}; bf16x2c_ b = __builtin_convertvector(v, bf16x2c_); return __builtin_bit_cast(unsigned, b); }

struct NaCtx { int klo, rq, s0q, qc, wstart; const ALAS float* tab; };
__device__ __forceinline__ void na_bias(f32x16& p0, f32x16& p1, int t, int hi, const NaCtx& c) {
  const int kr = c.klo + t; const bool active = (kr >= c.s0q) && (kr <= c.s0q + 7);
  if (!active) {
#pragma unroll
    for (int r = 0; r < 16; ++r) { p0[r] = -1e30f; p1[r] = -1e30f; }
    return;
  }
  const int tb = (kr - c.rq + 7) * 32 + 15 - c.qc;
#pragma unroll
  for (int r = 0; r < 16; ++r) {
    const int kc = crow(r, hi);
    { const bool v = (unsigned)(kc - c.wstart) < 16u; const float b = c.tab[v ? tb + kc : 0]; p0[r] = v ? p0[r] + b : -1e30f; }
    { const int k2 = kc + 32; const bool v = (unsigned)(k2 - c.wstart) < 16u; const float b = c.tab[v ? tb + k2 : 0]; p1[r] = v ? p1[r] + b : -1e30f; }
  }
}
__device__ __forceinline__ void k_issue(bf16x8 (&kf)[8], const ALAS char* Ks, int r32, int hi) {
#pragma unroll
  for (int d0 = 0; d0 < 4; ++d0) { const int cb = (d0 * 16 + hi * 8) * 2;
    kf[2 * d0] = *(const ALAS bf16x8*)(Ks + KSWZ(r32, cb)); kf[2 * d0 + 1] = *(const ALAS bf16x8*)(Ks + KSWZ(32 + r32, cb)); }
}
__device__ __forceinline__ void qkt(f32x16& p0, f32x16& p1, const bf16x8 (&kf)[8], const bf16x8* qr, const f32x16& cinit) {
  p0 = __builtin_amdgcn_mfma_f32_32x32x16_bf16(kf[0], qr[0], cinit, 0, 0, 0); p1 = __builtin_amdgcn_mfma_f32_32x32x16_bf16(kf[1], qr[0], cinit, 0, 0, 0);
#pragma unroll
  for (int d0 = 1; d0 < 4; ++d0) { p0 = __builtin_amdgcn_mfma_f32_32x32x16_bf16(kf[2 * d0], qr[d0], p0, 0, 0, 0); p1 = __builtin_amdgcn_mfma_f32_32x32x16_bf16(kf[2 * d0 + 1], qr[d0], p1, 0, 0, 0); }
}
template <int NC> __device__ __forceinline__ int v_st(int k, int c) { const int kk = (k & ~0xC) | ((k & 4) << 1) | ((k & 8) >> 1); return ((kk >> 3) * NC + (c >> 5)) * 512 + ((kk & 7) * 32 + (c & 31)) * 2; }
__device__ __forceinline__ int v_rd_base(int lane) { return ((lane & 3) << 3) | (((lane >> 2) & 3) << 6) | (((lane >> 4) & 1) << 5) | (((lane >> 5) & 1) << 8); }
template <int NC> constexpr int v_rd_off(int d0, int ks, int half) { return d0 * 512 + (2 * ks + half) * NC * 512; }
template <int OFF> __device__ __forceinline__ s16x4 tr_read(int vb) {
  s16x4 r; asm volatile("ds_read_b64_tr_b16 %0, %1 offset:%2" : "=&v"(r) : "v"(vb), "i"(OFF) : "memory"); return r;
}
template <int NC, int KS> __device__ __forceinline__ void v_issue_k(s16x4 (&L)[8], int vb) {
  L[0] = tr_read<v_rd_off<NC>(0, KS, 0)>(vb); L[1] = tr_read<v_rd_off<NC>(0, KS, 1)>(vb); L[2] = tr_read<v_rd_off<NC>(1, KS, 0)>(vb); L[3] = tr_read<v_rd_off<NC>(1, KS, 1)>(vb);
  if constexpr (NC == 4) { L[4] = tr_read<v_rd_off<NC>(2, KS, 0)>(vb); L[5] = tr_read<v_rd_off<NC>(2, KS, 1)>(vb); L[6] = tr_read<v_rd_off<NC>(3, KS, 0)>(vb); L[7] = tr_read<v_rd_off<NC>(3, KS, 1)>(vb); }
}
template <int NC> __device__ __forceinline__ void v_mma_k(f32x16* o, f32x16& osum, const s16x4 (&L)[8], bf16x8 pa, bf16x8 ones) {
#define PK(A, B) (bf16x8){A[0], A[1], A[2], A[3], B[0], B[1], B[2], B[3]}
  osum = __builtin_amdgcn_mfma_f32_32x32x16_bf16(pa, ones, osum, 0, 0, 0);
  o[0] = __builtin_amdgcn_mfma_f32_32x32x16_bf16(pa, PK(L[0], L[1]), o[0], 0, 0, 0);
  o[1] = __builtin_amdgcn_mfma_f32_32x32x16_bf16(pa, PK(L[2], L[3]), o[1], 0, 0, 0);
  if constexpr (NC == 4) { o[2] = __builtin_amdgcn_mfma_f32_32x32x16_bf16(pa, PK(L[4], L[5]), o[2], 0, 0, 0); o[3] = __builtin_amdgcn_mfma_f32_32x32x16_bf16(pa, PK(L[6], L[7]), o[3], 0, 0, 0); }
#undef PK
}
template <int DV, bool NA>
__device__ __forceinline__ void attn_core(const bf16_t* __restrict__ Qlane, const bf16_t* __restrict__ Kh, const bf16_t* __restrict__ Vh, const int NT,
                                          ALAS char* lds, f32x16 (&o)[DV / 32], const NaCtx& na) {
  constexpr int NC = DV / 32;
  int tid_ = threadIdx.x; asm volatile("" : "+v"(tid_));
  const int tid = tid_, wid = __builtin_amdgcn_readfirstlane(tid >> 6), lane = tid & 63, r32 = lane & 31, hi = lane >> 5;
  ALAS char* V_lds = lds + L_V; ALAS char* K_lds = lds + L_K;
  ALAS float* al_l = (ALAS float*)(lds + L_WS) + wid * 64;
  float m_ref = 0.f;
  f32x16 osum = f32x16{}, negm = f32x16{};
#pragma unroll
  for (int d = 0; d < NC; ++d) o[d] = f32x16{};
  bf16x8 qr[4];
#pragma unroll
  for (int d0 = 0; d0 < 4; ++d0) qr[d0] = *reinterpret_cast<const bf16x8*>(Qlane + d0 * 16);
  const bf16x8 ones = {0x3f80, 0x3f80, 0x3f80, 0x3f80, 0x3f80, 0x3f80, 0x3f80, 0x3f80};
  const int kr_ = tid >> 3, kc8 = (tid & 7) * 8, kst = KSWZ(kr_, kc8 * 2);
  const int vr_ = (DV == 128) ? (tid >> 4) : (tid >> 3), vc8 = (DV == 128) ? (tid & 15) * 8 : (tid & 7) * 8;
  const int vst0 = v_st<NC>(vr_, vc8), vst1 = v_st<NC>((32 + vr_) & 63, vc8);
  const int vb0 = (int)(uintptr_t)V_lds + v_rd_base(lane);
  const int kgo = kr_ * LD + kc8, vgo = vr_ * LD + vc8;
  bf16x8 sk0, sva0, svb0, sk1, sva1, svb1;
#define SLOADX(S, k0) do { sk##S = *reinterpret_cast<const bf16x8*>(Kh + (long)(k0) * LD + kgo); sva##S = *reinterpret_cast<const bf16x8*>(Vh + (long)(k0) * LD + vgo); \
    if constexpr (DV == 128) svb##S = *reinterpret_cast<const bf16x8*>(Vh + (long)((k0) + 32) * LD + vgo); } while (0)
#define SWRITEX(S, b) do { *(ALAS bf16x8*)(V_lds + (b) * SHM_V + vst0) = sva##S; if constexpr (DV == 128) *(ALAS bf16x8*)(V_lds + (b) * SHM_V + vst1) = svb##S; \
    *(ALAS bf16x8*)(K_lds + (b) * SHM_K + kst) = sk##S; } while (0)
#define ACT(t) (!NA || ((na.klo + (t)) >= na.s0q && (na.klo + (t)) <= na.s0q + 7))
  SLOADX(0, 0); asm volatile("s_waitcnt vmcnt(0)" ::: "memory"); SWRITEX(0, 0); SLOADX(1, 64); SLOADX(0, 128); __syncthreads();
  for (int jj = 0; jj < NT; jj += 2) {
#pragma unroll
   for (int par = 0; par < 2; ++par) {
    const int j = jj + par; const int b = par; const bool act = ACT(j);
    bf16x8 kf[8];
    if (act) k_issue(kf, K_lds + b * SHM_K, r32, hi);
    if (par == 0) { if (j + 1 < NT) { SWRITEX(1, 1); if (j + 3 < NT) SLOADX(1, (j + 3) * 64); } }
    else          { if (j + 1 < NT) { SWRITEX(0, 0); if (j + 3 < NT) SLOADX(0, (j + 3) * 64); } }
    if (act) {
      f32x16 p0, p1;
      qkt(p0, p1, kf, qr, negm);
      if constexpr (NA) na_bias(p0, p1, j, hi, na);
      float pmax = fmaxf(p0[0], p1[0]), pmx2 = fmaxf(p0[1], p1[1]);
#pragma unroll
      for (int r = 2; r < 16; r += 2) { pmax = __builtin_fmaxf(__builtin_fmaxf(pmax, p0[r]), p1[r]); pmx2 = __builtin_fmaxf(__builtin_fmaxf(pmx2, p0[r + 1]), p1[r + 1]); }
      pmax = fmaxf(pmax, pmx2);
      { auto rr = __builtin_amdgcn_permlane32_swap(__float_as_uint(pmax), __float_as_uint(pmax), false, false);
        pmax = fmaxf(__uint_as_float(rr[0]), __uint_as_float(rr[1])); }
      if (__builtin_expect(!__all(pmax <= THR2), 0)) {
        const float dl = fmaxf(pmax, 0.f); m_ref += dl;
#pragma unroll
        for (int r = 0; r < 16; ++r) { p0[r] -= dl; p1[r] -= dl; negm[r] = -m_ref; }
        const float f = __builtin_amdgcn_exp2f(-dl);
        if (hi == 0) al_l[r32] = f; asm volatile("s_waitcnt lgkmcnt(0)" ::: "memory");
#pragma unroll
        for (int r = 0; r < 16; ++r) { const float ar = al_l[crow(r, hi)]; osum[r] *= ar;
#pragma unroll
          for (int d = 0; d < NC; ++d) o[d][r] *= ar; }
      }
      const int vb = vb0 + b * SHM_V;
      s16x4 LA[8], LB[8]; bf16x8 pa;
#define PK4(P, BASE, OUT) do { unsigned a0 = cvtpk(P[BASE + 0], P[BASE + 1]), a1 = cvtpk(P[BASE + 2], P[BASE + 3]);   \
    unsigned b0 = cvtpk(P[BASE + 4], P[BASE + 5]), b1 = cvtpk(P[BASE + 6], P[BASE + 7]);                              \
    auto r0 = __builtin_amdgcn_permlane32_swap(a0, b0, false, false); auto r1 = __builtin_amdgcn_permlane32_swap(a1, b1, false, false); \
    u32x4 w = {r0[0], r1[0], r0[1], r1[1]}; OUT = *reinterpret_cast<bf16x8*>(&w); } while (0)
#define EXP8(P, BASE) do { _Pragma("unroll") for (int r = 0; r < 8; ++r) P[BASE + r] = __builtin_amdgcn_exp2f(P[BASE + r]); } while (0)
#define LGKM(n) asm volatile("s_waitcnt lgkmcnt(" #n ")" ::: "memory")
      v_issue_k<NC, 0>(LA, vb);
      EXP8(p0, 0); PK4(p0, 0, pa); SBAR();
      v_issue_k<NC, 1>(LB, vb); if constexpr (NC == 4) LGKM(8); else LGKM(4); SBAR(); v_mma_k<NC>(o, osum, LA, pa, ones); SBAR();
      EXP8(p0, 8); PK4(p0, 8, pa); SBAR();
      v_issue_k<NC, 2>(LA, vb); if constexpr (NC == 4) LGKM(8); else LGKM(4); SBAR(); v_mma_k<NC>(o, osum, LB, pa, ones); SBAR();
      EXP8(p1, 0); PK4(p1, 0, pa); SBAR();
      v_issue_k<NC, 3>(LB, vb); if constexpr (NC == 4) LGKM(8); else LGKM(4); SBAR(); v_mma_k<NC>(o, osum, LA, pa, ones); SBAR();
      EXP8(p1, 8); PK4(p1, 8, pa); SBAR();
      LGKM(0); SBAR(); v_mma_k<NC>(o, osum, LB, pa, ones);
#undef PK4
#undef EXP8
#undef LGKM
    }
    __syncthreads();
   }
  }
#pragma unroll
  for (int r = 0; r < 16; ++r) { const float rl = __builtin_amdgcn_rcpf(osum[r]);
#pragma unroll
    for (int d = 0; d < NC; ++d) o[d][r] *= rl; }
#undef SLOADX
#undef SWRITEX
#undef ACT
}
__device__ __forceinline__ bf16_t to_bf16(float v) { return (bf16_t)(cvtpk(v, 0.f) & 0xffffu); }

constexpr int NAW_V = 0, NAW_TAB = 131072, NAW_TSTRIDE = 2000, NAW_END = NAW_TAB + 8 * NAW_TSTRIDE;
__device__ __forceinline__ void na_wave_units(int gw, int NGW, const bf16_t* QA, bf16_t* AB, const float* rpb  , ALAS char* lds) {
  int tid_ = threadIdx.x; asm volatile("" : "+v"(tid_));
  const int tid = tid_, wid = __builtin_amdgcn_readfirstlane(tid >> 6), lane = tid & 63, r32 = lane & 31, hi = lane >> 5;
  const int h = gw & 7;
  ALAS char* Vw = lds + NAW_V + wid * 16384;
  ALAS float* tab = (ALAS float*)(lds + NAW_TAB + wid * NAW_TSTRIDE);
  for (int i = lane; i < 480; i += 64) { const int dr = i >> 5, dc = i & 31; tab[i] = (dc < 31) ? rpb[(h * 15 + dr) * 31 + dc] * 1.4426950408889634f : 0.f; }
  asm volatile("s_waitcnt lgkmcnt(0)" ::: "memory");
  const bf16x8 ones = {0x3f80, 0x3f80, 0x3f80, 0x3f80, 0x3f80, 0x3f80, 0x3f80, 0x3f80};
  const int vb0 = (int)(uintptr_t)Vw + v_rd_base(lane);
  int vgo[8], vso[8];
#pragma unroll
  for (int i = 0; i < 8; ++i) { const int p = i * 64 + lane, key = p >> 3, c8 = (p & 7) * 8; vgo[i] = key * LD + c8; vso[i] = v_st<2>(key, c8); }
  const int kgo0 = r32 * LD + hi * 8, kgo1 = (32 + r32) * LD + hi * 8;
  for (int wu = gw; wu < 20480; wu += NGW) {
    const int hf = (wu >> 3) & 1, rowg = wu >> 4;
    int base, r, rows;
    if (rowg < 256) { base = 0; r = rowg; rows = 256; } else { const int l = rowg - 256; base = 16384 + (l >> 6) * 4096; r = l & 63; rows = 64; }
    NaCtx c; c.s0q = min(max(r - 4, 0), rows - 8); c.klo = c.s0q; c.rq = r; c.qc = 32 * hf + r32; c.wstart = min(max(c.qc - 8, 0), 48); c.tab = tab;
    const long qrow = (long)base + r * 64 + hf * 32;
    const bf16_t* Qlane = QA + (qrow + r32) * LD + h * 64 + hi * 8;
    const bf16_t* Kb = QA + ((long)base + c.klo * 64) * LD + 512 + h * 64;
    const bf16_t* Vb = QA + ((long)base + c.klo * 64) * LD + 1024 + h * 64;
    bf16x8 qr[4];
#pragma unroll
    for (int d0 = 0; d0 < 4; ++d0) qr[d0] = *reinterpret_cast<const bf16x8*>(Qlane + d0 * 16);
    float m_ref = 0.f; f32x16 osum = f32x16{}, negm = f32x16{}, o[2]; o[0] = f32x16{}; o[1] = f32x16{};
    bf16x8 kf[8], vN[8];
#define KLOAD(t) do { _Pragma("unroll") for (int d0 = 0; d0 < 4; ++d0) { kf[2 * d0] = *reinterpret_cast<const bf16x8*>(Kb + (long)(t) * 64 * LD + kgo0 + d0 * 16); \
                                                                        kf[2 * d0 + 1] = *reinterpret_cast<const bf16x8*>(Kb + (long)(t) * 64 * LD + kgo1 + d0 * 16); } } while (0)
#define VLOAD(t) do { _Pragma("unroll") for (int i = 0; i < 8; ++i) vN[i] = *reinterpret_cast<const bf16x8*>(Vb + (long)(t) * 64 * LD + vgo[i]); } while (0)
#define VWRITE(b) do { _Pragma("unroll") for (int i = 0; i < 8; ++i) *(ALAS bf16x8*)(Vw + (b) * 8192 + vso[i]) = vN[i]; } while (0)
    KLOAD(0); VLOAD(0); VWRITE(0);
#pragma unroll
    for (int t = 0; t < 8; ++t) {
      const int b = t & 1;
      if (t + 1 < 8) VLOAD(t + 1);
      f32x16 p0, p1;
      qkt(p0, p1, kf, qr, negm);
      if (t + 1 < 8) { asm volatile("" ::: "memory"); KLOAD(t + 1); }
      na_bias(p0, p1, t, hi, c);
      float pmax = fmaxf(p0[0], p1[0]), pmx2 = fmaxf(p0[1], p1[1]);
#pragma unroll
      for (int q = 2; q < 16; q += 2) { pmax = __builtin_fmaxf(__builtin_fmaxf(pmax, p0[q]), p1[q]); pmx2 = __builtin_fmaxf(__builtin_fmaxf(pmx2, p0[q + 1]), p1[q + 1]); }
      pmax = fmaxf(pmax, pmx2);
      { auto rr = __builtin_amdgcn_permlane32_swap(__float_as_uint(pmax), __float_as_uint(pmax), false, false); pmax = fmaxf(__uint_as_float(rr[0]), __uint_as_float(rr[1])); }
      if (__builtin_expect(!__all(pmax <= THR2), 0)) {
        const float dl = fmaxf(pmax, 0.f); m_ref += dl;
#pragma unroll
        for (int q = 0; q < 16; ++q) { p0[q] -= dl; p1[q] -= dl; negm[q] = -m_ref; }
        const float f = __builtin_amdgcn_exp2f(-dl);
#pragma unroll
        for (int q = 0; q < 16; ++q) { const float ar = __shfl(f, crow(q, hi), 64); osum[q] *= ar; o[0][q] *= ar; o[1][q] *= ar; }
      }
#pragma unroll
      for (int q = 0; q < 16; ++q) { p0[q] = __builtin_amdgcn_exp2f(p0[q]); p1[q] = __builtin_amdgcn_exp2f(p1[q]); }
      bf16x8 pa0, pa1, pa2, pa3;
#define PK4(P, BASE, OUT) do { unsigned a0 = cvtpk(P[BASE + 0], P[BASE + 1]), a1 = cvtpk(P[BASE + 2], P[BASE + 3]);   \
    unsigned b0 = cvtpk(P[BASE + 4], P[BASE + 5]), b1 = cvtpk(P[BASE + 6], P[BASE + 7]);                              \
    auto r0 = __builtin_amdgcn_permlane32_swap(a0, b0, false, false); auto r1 = __builtin_amdgcn_permlane32_swap(a1, b1, false, false); \
    u32x4 w = {r0[0], r1[0], r0[1], r1[1]}; OUT = *reinterpret_cast<bf16x8*>(&w); } while (0)
      PK4(p0, 0, pa0); PK4(p0, 8, pa1); PK4(p1, 0, pa2); PK4(p1, 8, pa3);
#undef PK4
      { const int vb = vb0 + b * 8192; s16x4 LA[8], LB[8];
        v_issue_k<2, 0>(LA, vb); v_issue_k<2, 1>(LB, vb); asm volatile("s_waitcnt lgkmcnt(4)" ::: "memory"); SBAR(); v_mma_k<2>(o, osum, LA, pa0, ones); SBAR();
        v_issue_k<2, 2>(LA, vb); asm volatile("s_waitcnt lgkmcnt(4)" ::: "memory"); SBAR(); v_mma_k<2>(o, osum, LB, pa1, ones); SBAR();
        v_issue_k<2, 3>(LB, vb); asm volatile("s_waitcnt lgkmcnt(4)" ::: "memory"); SBAR(); v_mma_k<2>(o, osum, LA, pa2, ones); SBAR();
        asm volatile("s_waitcnt lgkmcnt(0)" ::: "memory"); SBAR(); v_mma_k<2>(o, osum, LB, pa3, ones); }
      if (t + 1 < 8) VWRITE(b ^ 1);
    }
#undef KLOAD
#undef VLOAD
#undef VWRITE
    bf16_t* Ow = AB + qrow * 1024 + h * 64 + r32;
#pragma unroll
    for (int q = 0; q < 16; ++q) { const float rl = __builtin_amdgcn_rcpf(osum[q]); const int orow = crow(q, hi);
      Ow[(long)orow * 1024] = to_bf16(o[0][q] * rl); Ow[(long)orow * 1024 + 32] = to_bf16(o[1][q] * rl); }
    asm volatile("s_waitcnt lgkmcnt(0)" ::: "memory");
  }
}
__device__ __forceinline__ void diff_unit(int base, int seq, int h, int qblk, const bf16_t* QB, bf16_t* AB, float lam, float one_m_li, const float* subln, ALAS char* lds) {
  int tid_ = threadIdx.x; asm volatile("" : "+v"(tid_));
  const int tid = tid_, wid = __builtin_amdgcn_readfirstlane(tid >> 6), lane = tid & 63, r32 = lane & 31, hi = lane >> 5;
  const int row0 = base + qblk * 256;
  ALAS unsigned* stash = (ALAS unsigned*)(lds + L_STASH) + wid * 2048;
  NaCtx c{};
  f32x16 o[4];
  for (int mp = 0; mp < 2; ++mp) {
    const bf16_t* Qlane = QB + (long)(row0 + wid * 32 + r32) * LD + h * 128 + mp * 64 + hi * 8;
    const bf16_t* Kh = QB + (long)base * LD + 512 + h * 128 + mp * 64;
    const bf16_t* Vh = QB + (long)base * LD + 1024 + h * 128;
    attn_core<128, false>(Qlane, Kh, Vh, seq >> 6, lds, o, c);
    if (mp == 0) {
#pragma unroll
      for (int d0 = 0; d0 < 4; ++d0)
#pragma unroll
        for (int r = 0; r < 16; r += 2) stash[(d0 * 8 + (r >> 1)) * 64 + lane] = cvtpk(o[d0][r], o[d0][r + 1]);
    }
  }
  asm volatile("s_waitcnt lgkmcnt(0)" ::: "memory");
  float sg[4];
#pragma unroll
  for (int d0 = 0; d0 < 4; ++d0) sg[d0] = subln[d0 * 32 + r32] * one_m_li;
  bf16_t* Ow = AB + (long)(row0 + wid * 32) * 1024 + 512 + h * 128 + r32;
#pragma unroll
  for (int r = 0; r < 16; r += 2) {
    float v0[4], v1[4]; float s0 = 0.f, s1 = 0.f;
#pragma unroll
    for (int d0 = 0; d0 < 4; ++d0) { const unsigned w = stash[(d0 * 8 + (r >> 1)) * 64 + lane];
      v0[d0] = __uint_as_float(w << 16) - lam * o[d0][r]; v1[d0] = __uint_as_float(w & 0xffff0000u) - lam * o[d0][r + 1];
      s0 += v0[d0] * v0[d0]; s1 += v1[d0] * v1[d0]; }
#pragma unroll
    for (int x = 1; x < 32; x <<= 1) { s0 += __shfl_xor(s0, x); s1 += __shfl_xor(s1, x); }
    const float rs0 = 1.0f / sqrtf(s0 * (1.0f / 128.0f) + 1e-5f), rs1 = 1.0f / sqrtf(s1 * (1.0f / 128.0f) + 1e-5f);
    const int or0 = crow(r, hi), or1 = crow(r + 1, hi);
#pragma unroll
    for (int d0 = 0; d0 < 4; ++d0) { Ow[(long)or0 * 1024 + d0 * 32] = to_bf16(v0[d0] * rs0 * sg[d0]); Ow[(long)or1 * 1024 + d0 * 32] = to_bf16(v1[d0] * rs1 * sg[d0]); }
  }
}
#undef SBAR
}
#define LAS __attribute__((address_space(3)))
typedef unsigned short bf16;
typedef unsigned v4u __attribute__((ext_vector_type(4)));
typedef unsigned v2u __attribute__((ext_vector_type(2)));
typedef float f32x4 __attribute__((ext_vector_type(4)));
constexpr int NWAVES = 8;
constexpr int MTOK = 81920, NP = 16384, DM = 1024, DFF = 2816, NLAYER = 2;
constexpr size_t MiB = 1u << 20;
constexpr size_t WS_GNH = 64 * 1024;
constexpr size_t WS_RPB = 128 * 1024, WS_SUB = 192 * 1024, WS_LAM = 200 * 1024;
constexpr size_t WS_ROPE = 1 * MiB;
constexpr size_t WS_W = 4 * MiB, WS_WL = 48 * MiB;
constexpr size_t WS_H = 104 * MiB;
constexpr size_t WS_R = 264 * MiB;
constexpr size_t WS_T = WS_R;
constexpr size_t WS_QA = WS_R, WS_QB = WS_R + 240 * MiB, WS_AB = WS_R + 480 * MiB;
constexpr size_t WS_G = WS_R, WS_MG = WS_R + 320 * MiB;
constexpr size_t WS_SS = WS_R + 640 * MiB;
constexpr size_t WS_END = WS_SS + 6 * MiB;
constexpr size_t WO_WI1 = 0, WO_WO1 = WO_WI1 + (size_t)5632 * 1024, WO_QKV = WO_WO1 + (size_t)1024 * 2816, WO_G = WO_QKV + (size_t)3072 * 1024,
                 WO_AB = WO_G + (size_t)2048 * 1024, WO_OUT = WO_AB + (size_t)1024 * 1024, WO_WI2 = WO_OUT + (size_t)1024 * 1024, WO_WO2 = WO_WI2 + (size_t)5632 * 1024,
                 WO_END = WO_WO2 + (size_t)1024 * 2816;
static_assert(WO_END * 2 <= WS_WL, "weight block");
constexpr int RING_BYTES = 131072, LDS_BYTES = 147456;
static_assert(att::L_END <= LDS_BYTES && att::NAW_END <= LDS_BYTES - 64, "attention LDS");

#define LDS_WAIT() asm volatile("s_waitcnt lgkmcnt(0)" ::: "memory")
__device__ __forceinline__ unsigned f2bf(float f) { unsigned u = __builtin_bit_cast(unsigned, f); return (u + 0x7fffu + ((u >> 16) & 1u)) >> 16; }
__device__ __forceinline__ unsigned pk2(float lo, float hi) { return f2bf(lo) | (f2bf(hi) << 16); }
__device__ __forceinline__ float wave_sum(float v) {
#pragma unroll
    for (int o = 1; o < 64; o <<= 1) v += __shfl_xor(v, o);
    return v;
}
__device__ __forceinline__ void tr_item(const float* W, int N, int k0, int n0, bf16* dst, int drow0, int ldd, int koff, LAS float* scr, int lane, const float* g = nullptr) {
    {   const int kr = lane >> 3, c4 = (lane & 7) * 4;
        f32x4 wv[8];
#pragma unroll
        for (int i = 0; i < 8; ++i) wv[i] = *(const f32x4*)(W + (size_t)(k0 + i * 8 + kr) * N + n0 + c4);
#pragma unroll
        for (int i = 0; i < 8; ++i) { const int kk = i * 8 + kr; const float gk = g ? g[k0 + kk] : 1.0f; LAS float* d = scr + kk * 33 + c4;
            d[0] = wv[i][0] * gk; d[1] = wv[i][1] * gk; d[2] = wv[i][2] * gk; d[3] = wv[i][3] * gk; } }
    LDS_WAIT(); asm volatile("" ::: "memory");
    const int c = lane & 7;
#pragma unroll
    for (int j = 0; j < 4; ++j) { const int n = (lane >> 3) + 8 * j; const LAS float* s = scr + (8 * c) * 33 + n;
        v4u o; o.x = pk2(s[0 * 33], s[1 * 33]); o.y = pk2(s[2 * 33], s[3 * 33]); o.z = pk2(s[4 * 33], s[5 * 33]); o.w = pk2(s[6 * 33], s[7 * 33]);
        *(v4u*)(dst + (size_t)(drow0 + n) * ldd + koff + k0 + 8 * c) = o; }
    LDS_WAIT(); asm volatile("" ::: "memory");
}
__device__ __forceinline__ void xb_row(const float* xrow, bf16* orow, float* ssrow, int lane) {
    const f32x4* xr = (const f32x4*)xrow + lane;
    f32x4 v[4]; float s = 0.f;
#pragma unroll
    for (int j = 0; j < 4; ++j) { v[j] = xr[64 * j]; s += (v[j].x * v[j].x + v[j].y * v[j].y) + (v[j].z * v[j].z + v[j].w * v[j].w); }
    s = wave_sum(s);
    v2u* o8 = (v2u*)orow + lane;
#pragma unroll
    for (int j = 0; j < 4; ++j) { v2u w; w.x = pk2(v[j].x, v[j].y); w.y = pk2(v[j].z, v[j].w); o8[64 * j] = w; }
    if (lane < 16) ssrow[lane] = (lane == 0) ? s : 0.f;
}

constexpr size_t WS_BAR = 256 * 1024;
#define RLX_AGENT __ATOMIC_RELAXED, __HIP_MEMORY_SCOPE_AGENT
#define XB_TMO      128
#define XB_XCNT(j)  (256  + 64 * (j))
#define XB_XSUB(j)  (1280 + 64 * (j))
#define XB_XGEN(j)  (2304 + 64 * (j))
#define XB_TOP      3328
#define XB_TOPGEN   3392
#define XCD_BAR_WORDS 3456
#define XB_SPIN_CAP (1u << 18)

__device__ __forceinline__ unsigned xb_ld(unsigned* p)              { return __hip_atomic_load(p, __ATOMIC_RELAXED, __HIP_MEMORY_SCOPE_AGENT); }
__device__ __forceinline__ unsigned xb_add(unsigned* p, unsigned v) { return __hip_atomic_fetch_add(p, v, __ATOMIC_RELAXED, __HIP_MEMORY_SCOPE_AGENT); }
__device__ __forceinline__ unsigned xb_xcc_id() { return (unsigned)__builtin_amdgcn_s_getreg((3 << 11) | 20) & 0xFu; }
#define XB_SPIN(cond, bar) do { unsigned _sp = 0; while (cond) { __builtin_amdgcn_s_sleep(1); \
    if ((++_sp & 255u) == 0u) { if (xb_ld(&(bar)[XB_TMO])) break; if (_sp > XB_SPIN_CAP) { atomicAdd(&(bar)[XB_TMO], 1u); break; } } } } while (0)

struct XcdBarrier {
    unsigned* bar; unsigned x;
    volatile LAS unsigned* st;
};

__device__ __forceinline__ XcdBarrier xcd_barrier_post(unsigned* bar, volatile LAS unsigned* st) {
    XcdBarrier b; b.bar = bar; b.x = xb_xcc_id(); b.st = st;
    if (threadIdx.x == 0) (void)xb_add(&bar[XB_XCNT(b.x)], 1u);
    return b;
}
__device__ __forceinline__ void xcd_barrier_complete(unsigned* bar, unsigned x, unsigned& nloc, unsigned& nx) {
    const unsigned G = gridDim.x * gridDim.y * gridDim.z;
    unsigned sum, cnt, mine, sp = 0u;
    for (;;) {
        sum = 0u; cnt = 0u; mine = 0u;
#pragma unroll
        for (unsigned j = 0; j < 16; ++j) { const unsigned c = xb_ld(&bar[XB_XCNT(j)]); sum += c; cnt += (c > 0u) ? 1u : 0u; mine = (j == x) ? c : mine; }
        if (sum == G) break;
        __builtin_amdgcn_s_sleep(1);
        if ((++sp & 255u) == 0u) { if (xb_ld(&bar[XB_TMO])) break; if (sp > XB_SPIN_CAP) { atomicAdd(&bar[XB_TMO], 1u); break; } }
    }
    nloc = mine > 0u ? mine : 1u; nx = cnt > 0u ? cnt : 1u;
}

__device__ __forceinline__ void xcd_barrier(const XcdBarrier& b) {
    asm volatile("s_waitcnt vmcnt(0)" ::: "memory");
    __syncthreads();
    if (threadIdx.x == 0) {
        unsigned* bar = b.bar;
        __builtin_amdgcn_s_waitcnt(0);
        unsigned nloc = b.st[0], nx = b.st[1];
        if (nloc == 0u) { xcd_barrier_complete(bar, b.x, nloc, nx); b.st[0] = nloc; b.st[1] = nx; }
        const unsigned old = xb_add(&bar[XB_XSUB(b.x)], 1u);
        const unsigned gen = old / nloc;
        if (old + 1u == (gen + 1u) * nloc) {
            __builtin_amdgcn_fence(__ATOMIC_RELEASE, "agent");
            asm volatile("s_waitcnt vmcnt(0)" ::: "memory");
            const unsigned og = xb_add(&bar[XB_TOP], 1u);
            const unsigned tg = og / nx;
            if (og + 1u == (tg + 1u) * nx) xb_add(&bar[XB_TOPGEN], 1u);
            else XB_SPIN(xb_ld(&bar[XB_TOPGEN]) == tg, bar);
            __builtin_amdgcn_fence(__ATOMIC_ACQUIRE, "agent");
            xb_add(&bar[XB_XGEN(b.x)], 1u);
            asm volatile("s_waitcnt vmcnt(0)" ::: "memory");
        } else {
            XB_SPIN(xb_ld(&bar[XB_XGEN(b.x)]) == gen, bar);
            __builtin_amdgcn_fence(__ATOMIC_ACQUIRE, "agent");
            asm volatile("s_waitcnt vmcnt(0)" ::: "memory");
        }
    }
    __syncthreads();
}

#define GSYNC() xcd_barrier(xbar)
struct Args { const float* in[23]; float* out; unsigned char* ws; };

__global__ void __launch_bounds__(NWAVES * 64, 2) mega_fwd(Args a) {
    extern __shared__ __attribute__((aligned(16))) unsigned char lds_raw[];
    cg::grid_group grid = cg::this_grid();
    LAS unsigned char* lds = (LAS unsigned char*)lds_raw;
    const int tid = threadIdx.x, lane = tid & 63, wave = __builtin_amdgcn_readfirstlane(tid >> 6);
    const int G = gridDim.x, bx = blockIdx.x;
    const int vcu = (G % 8 == 0) ? (bx % 8) * (G / 8) + bx / 8 : bx;
    const int gw = vcu * NWAVES + wave, NGW = G * NWAVES;
    unsigned char* ws = a.ws;
    volatile LAS unsigned* xb_st = (volatile LAS unsigned*)(lds + LDS_BYTES - 64);
    if (tid < 2) xb_st[tid] = 0u;
    __syncthreads();
    const XcdBarrier xbar = xcd_barrier_post((unsigned*)(ws + WS_BAR), xb_st);
    float* xbuf = a.out;
    bf16* Hb = (bf16*)(ws + WS_H); bf16* Tb = (bf16*)(ws + WS_T); bf16* QAb = (bf16*)(ws + WS_QA); bf16* QBb = (bf16*)(ws + WS_QB);
    bf16* ABb = (bf16*)(ws + WS_AB); bf16* Gb = (bf16*)(ws + WS_G); bf16* MGb = (bf16*)(ws + WS_MG); float* rope = (float*)(ws + WS_ROPE); float* SSb = (float*)(ws + WS_SS); float* gnh = (float*)(ws + WS_GNH); float* rpbw = (float*)(ws + WS_RPB); float* subw = (float*)(ws + WS_SUB); float* lamw = (float*)(ws + WS_LAM);

    {
        LAS float* scr = (LAS float*)(lds + wave * 16384);
        constexpr int I0 = 16 * 176, I1 = 44 * 32, I2 = 16 * 160, I3 = 8 * 32, I4 = 8 * 32, I5 = 16 * 32, I6 = I0, I7 = I1;
        constexpr int NI = I0 + I1 + I2 + I3 + I4 + I5 + I6 + I7;
        for (int it = gw; it < NLAYER * NI; it += NGW) {
            const int l = it / NI; int r = it % NI;
            bf16* wl = (bf16*)(ws + WS_W + (size_t)l * WS_WL);
            if (r < I0 || (r >= I0 + I1 + I2 + I3 + I4 + I5 && r < NI - I7)) {
                const bool second = r >= I0; if (second) r -= I0 + I1 + I2 + I3 + I4 + I5;
                const float* W = a.in[second ? 21 : 3] + (size_t)l * 1024 * 5632;
                const int kb = r / 176, nb = r % 176, n0 = nb * 32; const int bj = n0 >= 2816, j = n0 - bj * 2816;
                tr_item(W, 5632, kb * 64, n0, wl + (second ? WO_WI2 : WO_WI1), 256 * (j >> 7) + 128 * bj + (j & 127), 1024, 0, scr, lane, a.in[second ? 20 : 2] + (size_t)l * DM);
                continue;
            }
            if (r >= NI - I7) { r -= NI - I7; const float* W = a.in[22] + (size_t)l * 2816 * 1024; const int kb = r / 32, nb = r % 32;
                tr_item(W, 1024, kb * 64, nb * 32, wl + WO_WO2, nb * 32, 2816, 0, scr, lane); continue; }
            r -= I0;
            if (r < I1) { const float* W = a.in[4] + (size_t)l * 2816 * 1024; const int kb = r / 32, nb = r % 32;
                tr_item(W, 1024, kb * 64, nb * 32, wl + WO_WO1, nb * 32, 2816, 0, scr, lane); continue; }
            r -= I1;
            if (r < I2) { const float* W = a.in[6] + (size_t)l * 1024 * 5120; const int kb = r / 160, nb = r % 160, n0 = nb * 32;
                if (n0 < 3072) { const int blk = n0 >> 8, o = n0 & 255, hh = o >> 6, bb = (o & 63) >> 5;
                    tr_item(W, 5120, kb * 64, n0, wl + WO_QKV, blk * 256 + 128 * bb + 32 * hh, 1024, 0, scr, lane, a.in[5] + (size_t)l * DM); }
                else { const int np = n0 - 3072, pb = np >= 1024, j = np - pb * 1024;
                    tr_item(W, 5120, kb * 64, n0, wl + WO_G, 256 * (j >> 7) + 128 * pb + (j & 127), 1024, 0, scr, lane, a.in[5] + (size_t)l * DM); }
                continue; }
            r -= I2;
            if (r < I3) { const float* W = a.in[17] + (size_t)l * 512 * 1024; const int kb = r / 32, nb = r % 32;
                tr_item(W, 1024, kb * 64, nb * 32, wl + WO_AB, nb * 32, 512, 0, scr, lane); continue; }
            r -= I3;
            if (r < I4) { const float* W = a.in[18] + (size_t)l * 512 * 1024; const int kb = r / 32, nb = r % 32;
                tr_item(W, 1024, kb * 64, nb * 32, wl + WO_AB, 1024 + nb * 32, 512, 0, scr, lane); continue; }
            r -= I4;
            { const float* W = a.in[19] + (size_t)l * 1024 * 1024; const int kb = r / 32, nb = r % 32;
                tr_item(W, 1024, kb * 64, nb * 32, wl + WO_OUT, nb * 32, 1024, 0, scr, lane); }
        }
        for (int mrow = gw; mrow < MTOK; mrow += NGW)
            xb_row(mrow < NP ? a.in[0] + (size_t)mrow * DM : a.in[1] + (size_t)(mrow - NP) * DM, Hb + (size_t)mrow * DM, SSb + (size_t)mrow * 16, lane);
        for (int idx = (vcu * NWAVES * 64 + tid); idx < NLAYER * 6 * 64; idx += G * NWAVES * 64) {
            const int l = idx / 384, p = (idx / 64) % 6, c = idx % 64;
            gnh[idx] = (p == 0) ? a.in[7][l * 64 + c] : (p == 1) ? a.in[8][l * 64 + c] : (p == 3) ? a.in[10][l * 64 + c] : (p == 4) ? a.in[11][l * 64 + c] : 1.0f;
        }
        for (int idx = (vcu * NWAVES * 64 + tid); idx < NLAYER * 3720; idx += G * NWAVES * 64) rpbw[idx] = a.in[9][idx];
        for (int idx = (vcu * NWAVES * 64 + tid); idx < NLAYER * 128; idx += G * NWAVES * 64) subw[idx] = a.in[16][idx];
        if (vcu == 0 && wave < NLAYER) { const int l = wave;
            const float s1 = wave_sum(a.in[12][l * 64 + lane] * a.in[13][l * 64 + lane]), s2 = wave_sum(a.in[14][l * 64 + lane] * a.in[15][l * 64 + lane]);
            if (lane == 0) lamw[l] = expf(s1) - expf(s2) + (0.8f - 0.6f * expf(-0.3f * (float)l)); }
        for (int idx = (vcu * NWAVES * 64 + tid); idx < NP * 8; idx += G * NWAVES * 64) {
            const int pos = idx >> 3, i = idx & 7;
            const float invf = (i == 0) ? 1.0f : (i == 1) ? 0.19392274474868576f : (i == 2) ? 0.03760603093086393f : (i == 3) ? 0.007292664737217109f :
                               (i == 4) ? 0.001414213562373095f : (i == 5) ? 0.0002742481756762073f : (i == 6) ? 5.318295896944988e-05f : 1.031338537721246e-05f;
            const float angf = (float)pos * invf;
            const double ang = (double)angf; const double k = __builtin_rint(ang * 0.15915494309189535); const double r = __builtin_fma(-k, 6.283185307179586, ang) - k * 2.4492935982947064e-16;
            const double x2 = r * r; double ts = 1.0, tc = 1.0, ss = 1.0, sc = 1.0;
#pragma unroll
            for (int q = 1; q <= 14; ++q) { tc = -tc * x2 * (1.0 / (double)((2 * q - 1) * (2 * q))); ts = -ts * x2 * (1.0 / (double)((2 * q) * (2 * q + 1))); sc += tc; ss += ts; }
            rope[pos * 16 + i] = (float)sc; rope[pos * 16 + 8 + i] = (float)(ss * r);
        }
    }
    GSYNC();
    grid.sync();

    float lam = 0.f, one_m_li = 1.f;
    for (int ph = 0; ph < NLAYER * 9; ++ph) {
        const int l = ph / 9, k = ph % 9;
        const bf16* wl = (const bf16*)(ws + WS_W + (size_t)l * WS_WL);
        const bool first_x = (ph == 1);
        if (k == 0 || k == 7) {
            pg8::Gemm g{Hb, wl + (k == 0 ? WO_WI1 : WO_WI2), MTOK, 5632, 1024}; pg8::StaticOrder S; S.init(MTOK, 5632, G, bx, ph & 1);
            pg8::EpiSwiglu E{Tb, SSb};
            pg8::gemm_phase<pg8::EpiSwiglu, pg8::StaticOrder, true, true>(lds, g, S, E);
        } else if (k == 1 || k == 6 || k == 8) {
            pg8::Gemm g{k == 6 ? MGb : Tb, wl + (k == 1 ? WO_WO1 : k == 6 ? WO_OUT : WO_WO2), MTOK, 1024, k == 6 ? 1024 : 2816}; pg8::StaticOrder S; S.init(MTOK, 1024, G, bx, ph & 1);
            pg8::EpiResid E{xbuf, k == 6 ? 1.0f : 0.5f, Hb, SSb, (ph == NLAYER * 9 - 1) ? 1 : 0};
            pg8::gemm_phase<pg8::EpiResid, pg8::StaticOrder, true, true>(lds, g, S, E);
        } else if (k == 2) {
            pg8::Gemm g{Hb, wl + WO_QKV, MTOK, 3072, 1024}; pg8::StaticOrder S; S.init(MTOK, 3072, G, bx, ph & 1);
            pg8::EpiQKV E{QAb, QBb, gnh + l * 384, rope, SSb};
            pg8::gemm_phase<pg8::EpiQKV, pg8::StaticOrder, true, true>(lds, g, S, E);
        } else if (k == 3) {
            const float li = 0.8f - 0.6f * expf(-0.3f * (float)l);
            lam = lamw[l]; one_m_li = 1.0f - li;
            const float* subln = subw + l * 128;
            for (int u = vcu; u < 256 + 1024; u += G) {
                if (u < 256) att::diff_unit(0, NP, u >> 6, u & 63, QBb, ABb, lam, one_m_li, subln, (LAS char*)lds);
                else { const int v = u - 256; att::diff_unit(NP + (v >> 6) * 4096, 4096, (v >> 4) & 3, v & 15, QBb, ABb, lam, one_m_li, subln, (LAS char*)lds); }
            }
            const float* rpb = rpbw + (size_t)l * 8 * 15 * 31;
            __syncthreads();
            att::na_wave_units(gw, NGW, QAb, ABb, rpb, (LAS char*)lds);
        } else if (k == 4) {
            pg8::Gemm g{ABb, wl + WO_AB, MTOK, 2048, 512, 1024, 1024}; pg8::StaticOrder S; S.init(MTOK, 2048, G, bx, ph & 1);
            pg8::EpiY E{Gb};
            pg8::gemm_phase<pg8::EpiY, pg8::StaticOrder, false, true>(lds, g, S, E);
        } else {
            pg8::Gemm g{Hb, wl + WO_G, MTOK, 2048, 1024}; pg8::StaticOrder S; S.init(MTOK, 2048, G, bx, ph & 1);
            pg8::EpiGateMerge E{Gb, MGb, SSb};
            pg8::gemm_phase<pg8::EpiGateMerge, pg8::StaticOrder, true, true>(lds, g, S, E);
        }
        if (ph != NLAYER * 9 - 1) GSYNC();
    }
}

extern "C" void kernel_launch(void* const* d_in, const int* in_sizes, int n_in, void* d_out, int out_size, void* d_ws, size_t ws_size, hipStream_t stream) {
    static int grid = 0;
    if (grid == 0) {
        if (n_in != 23 || out_size != MTOK * DM || ws_size < WS_END) { fprintf(stderr, "kernel_launch: unexpected shapes: n_in %d out %d ws %zu (need >= %zu)\n", n_in, out_size, ws_size, (size_t)WS_END); grid = -1; return; }
        int dev = 0, cus = 0, per_cu = 0;
        (void)hipGetDevice(&dev); (void)hipDeviceGetAttribute(&cus, hipDeviceAttributeMultiprocessorCount, dev);
        if (hipFuncSetAttribute((const void*)mega_fwd, hipFuncAttributeMaxDynamicSharedMemorySize, LDS_BYTES) != hipSuccess) { fprintf(stderr, "kernel_launch: hipFuncSetAttribute failed\n"); grid = -1; return; }
        if (hipOccupancyMaxActiveBlocksPerMultiprocessor(&per_cu, (const void*)mega_fwd, NWAVES * 64, LDS_BYTES) != hipSuccess || per_cu < 1) { fprintf(stderr, "kernel_launch: occupancy query says %d\n", per_cu); per_cu = 1; }
        (void)hipGetLastError();
        grid = cus * per_cu;
        fprintf(stderr, "kernel_launch: grid %d (cus %d x %d)\n", grid, cus, per_cu);
    }
    if (grid < 0) return;
    if (hipMemsetAsync((char*)d_ws + WS_BAR, 0, 16384, stream) != hipSuccess) { fprintf(stderr, "kernel_launch: memset failed\n"); return; }
    Args a{};
    for (int i = 0; i < 23; ++i) a.in[i] = (const float*)d_in[i];
    a.out = (float*)d_out; a.ws = (unsigned char*)d_ws;
    void* args[] = {&a};
    const hipError_t e = hipLaunchCooperativeKernel((const void*)mega_fwd, dim3(grid), dim3(NWAVES * 64), args, LDS_BYTES, stream);
    if (e != hipSuccess) fprintf(stderr, "kernel_launch: cooperative launch failed: %s (grid %d)\n", hipGetErrorString(e), grid);
}
```

```cpp
#include <hip/hip_runtime.h>
#include <hip/hip_cooperative_groups.h>
#include <cstdio>
#include <cstdint>
namespace cg = cooperative_groups;
namespace pg8 {
#define PG8_LAS __attribute__((address_space(3)))
typedef unsigned short bf16_t;
typedef short bf16x8 __attribute__((ext_vector_type(8)));
typedef float f32x4 __attribute__((ext_vector_type(4)));
typedef unsigned u32x4 __attribute__((ext_vector_type(4)));
constexpr int BM = 256, BK = 64, HALF = 128, HTB = HALF * BK * 2  , STAGE_BYTES = 8 * HTB, NXCD = 8, WGM = 8;

__host__ __device__ __forceinline__ int lds_byte(int r, int c) { const int st = (r >> 4) * 2 + (c >> 5), rr = r & 15, cc = c & 31, ob = rr * 64 + cc * 2; return st * 1024 + (ob ^ (((ob >> 9) & 1) << 5)); }
__host__ __device__ __forceinline__ void stage_rc(int b, int& R, int& C) { const int st = b / 1024, sb = b % 1024, swz = sb ^ (((sb >> 9) & 1) << 5); R = (st >> 1) * 16 + swz / 64; C = (st & 1) * 32 + (swz % 64) / 2; }
__host__ __device__ __forceinline__ int perm32(int rho) { const int n = rho >> 4, i = rho & 15; return 8 * (i >> 2) + 4 * n + (i & 3); }

struct Unit { int pm, pn; };
struct Gemm { const bf16_t* A; const bf16_t* Bt; int M, N, K; int lda = 0, aselb = 0; };

struct StaticOrder {
    int nM, nN, nwg, G, c, nr, rev;
    __host__ __device__ void init(int M, int N, int G_, int c_, int rev_ = 0) { nM = M / BM; nN = N / BM; nwg = nM * nN; G = G_; c = c_; rev = rev_; nr = (c < nwg) ? (nwg - c + G - 1) / G : 0; }
    __host__ __device__ bool next(int i, Unit& u) const {
        if (i >= nr) return false;
        const long L = (long)(rev ? nr - 1 - i : i) * G + c;
        int wgid = (int)L; { const int q = nwg / NXCD, r = nwg % NXCD, xcd = wgid % NXCD, off = wgid / NXCD; wgid = (xcd < r ? xcd * (q + 1) : r * (q + 1) + (xcd - r) * q) + off; }
        const int nig = WGM * nN, gid = wgid / nig, fm = gid * WGM, gsz = (nM - fm) < WGM ? (nM - fm) : WGM;
        u.pm = fm + ((wgid % nig) % gsz); u.pn = (wgid % nig) / gsz; return true;
    }
    __device__ __forceinline__ void a_ready(const Unit&) const {}
    __device__ __forceinline__ void done(const Unit&) const {}
};

typedef float f32x2c_ __attribute__((ext_vector_type(2))); typedef __bf16 bf16x2c_ __attribute__((ext_vector_type(2)));
__device__ __forceinline__ unsigned cvt_pk_bf16(float lo, float hi) { f32x2c_ v = {lo, hi}; bf16x2c_ b = __builtin_convertvector(v, bf16x2c_); return __builtin_bit_cast(unsigned, b); }
typedef float f32x2 __attribute__((ext_vector_type(2)));
typedef unsigned u32x2 __attribute__((ext_vector_type(2)));
constexpr int DM_ = 1024, DFF_ = 2816, LDQKV_ = 1536, LDG_ = 2048;
constexpr float LOG2E_ = 1.4426950408889634f;
constexpr float QSCALE_ = 0.125f * 1.4426950408889634f;
__device__ __forceinline__ float sigm(float x) { return __builtin_amdgcn_rcpf(1.f + __builtin_amdgcn_exp2f(-LOG2E_ * x)); }
__device__ __forceinline__ float bf_lo(unsigned w) { return __uint_as_float(w << 16); }
__device__ __forceinline__ float bf_hi(unsigned w) { return __uint_as_float(w & 0xffff0000u); }
__device__ __forceinline__ u32x4 pack8(const f32x4 a, const f32x4 b) { u32x4 w; w.x = cvt_pk_bf16(a[0], a[1]); w.y = cvt_pk_bf16(a[2], a[3]); w.z = cvt_pk_bf16(b[0], b[1]); w.w = cvt_pk_bf16(b[2], b[3]); return w; }


__device__ __forceinline__ void row_rstd(const float* SS, int row0, int fq, float (&rs)[2][4]) {
    f32x4 pv[2][4];
#pragma unroll
    for (int ai = 0; ai < 2; ++ai)
#pragma unroll
        for (int m = 0; m < 4; ++m) pv[ai][m] = *(const f32x4*)(SS + (size_t)(row0 + ai * HALF + m * 16) * 16 + 4 * fq);
#pragma unroll
    for (int ai = 0; ai < 2; ++ai)
#pragma unroll
        for (int m = 0; m < 4; ++m) { float s = (pv[ai][m][0] + pv[ai][m][1]) + (pv[ai][m][2] + pv[ai][m][3]); s += __shfl_xor(s, 16); s += __shfl_xor(s, 32);
            rs[ai][m] = 1.0f / sqrtf(s * (1.0f / 1024.0f) + 1e-6f); }
}

struct EpiSwiglu {
    static constexpr bool PERM = true, AFTER_DRAIN = false, MID = false;
    bf16_t* T; const float* SS;
    __device__ __forceinline__ void operator()(const f32x4 (&acc)[2][2][4][2], const Unit& u, int wr, int wc, int fr, int fq) const {
        const int row0 = u.pm * BM + wr * 64 + fr, col0 = u.pn * 128 + wc * 32 + 8 * fq;
        float rs[2][4]; row_rstd(SS, row0, fq, rs);
#pragma unroll
        for (int ai = 0; ai < 2; ++ai)
#pragma unroll
            for (int m = 0; m < 4; ++m) {
                bf16_t* rowp = T + (size_t)(row0 + ai * HALF + m * 16) * DFF_ + col0;
                f32x4 v[2];
#pragma unroll
                for (int n = 0; n < 2; ++n)
#pragma unroll
                    for (int i = 0; i < 4; ++i) { const float a = acc[ai][0][m][n][i] * rs[ai][m], b = acc[ai][1][m][n][i] * rs[ai][m]; v[n][i] = a * sigm(a) * b; }
                *(u32x4*)rowp = pack8(v[0], v[1]);
            }
    }
};
struct EpiResid {
    static constexpr bool PERM = true, AFTER_DRAIN = false, MID = false;
    float* xout; float s; bf16_t* XB; float* SS; int final_;
    __device__ __forceinline__ void operator()(const f32x4 (&acc)[2][2][4][2], const Unit& u, int wr, int wc, int fr, int fq) const {
        const int col0 = u.pn * BM + wc * 32 + 8 * fq;
        u32x4 xall[2][4][2];
#pragma unroll
        for (int ai = 0; ai < 2; ++ai)
#pragma unroll
            for (int m = 0; m < 4; ++m)
#pragma unroll
                for (int bj = 0; bj < 2; ++bj) xall[ai][m][bj] = *(const u32x4*)(XB + (size_t)(u.pm * BM + ai * HALF + wr * 64 + m * 16 + fr) * DM_ + col0 + bj * HALF);
#pragma unroll
        for (int ai = 0; ai < 2; ++ai)
#pragma unroll
            for (int m = 0; m < 4; ++m) {
                const int row = u.pm * BM + ai * HALF + wr * 64 + m * 16 + fr;
                const size_t off = (size_t)row * DM_ + col0;
                u32x4 xb[2];
#pragma unroll
                for (int bj = 0; bj < 2; ++bj) xb[bj] = xall[ai][m][bj];
                float ss = 0.f;
#pragma unroll
                for (int bj = 0; bj < 2; ++bj) {
                    f32x4 xv[2];
#pragma unroll
                    for (int w = 0; w < 4; ++w) { xv[w >> 1][(w & 1) * 2] = bf_lo(xb[bj][w]) + acc[ai][bj][m][w >> 1][(w & 1) * 2] * s; xv[w >> 1][(w & 1) * 2 + 1] = bf_hi(xb[bj][w]) + acc[ai][bj][m][w >> 1][(w & 1) * 2 + 1] * s; }
                    if (final_) { *(f32x4*)(xout + off + bj * HALF) = xv[0]; *(f32x4*)(xout + off + bj * HALF + 4) = xv[1]; }
                    else {
#pragma unroll
                        for (int n = 0; n < 2; ++n) ss += (xv[n][0] * xv[n][0] + xv[n][1] * xv[n][1]) + (xv[n][2] * xv[n][2] + xv[n][3] * xv[n][3]);
                        *(u32x4*)(XB + off + bj * HALF) = pack8(xv[0], xv[1]);
                    }
                }
                if (!final_) { ss += __shfl_xor(ss, 16); ss += __shfl_xor(ss, 32); if (fq == 0) SS[(size_t)row * 16 + u.pn * 4 + wc] = ss; }
                asm volatile("" ::: "memory");
            }
    }
};
struct EpiQKV {
    static constexpr bool PERM = true, AFTER_DRAIN = false, MID = false;
    bf16_t* QA; bf16_t* QB; const float* gn; const float* rope; const float* SS;
    __device__ __forceinline__ void operator()(const f32x4 (&acc)[2][2][4][2], const Unit& u, int wr, int wc, int fr, int fq) const {
        const int part = u.pn >> 1, sub = u.pn & 1, p3 = part % 3;
        bf16_t* dst = (part < 3) ? QA : QB;
        const int pcol = p3 * 512 + sub * 256 + wc * 64 + 8 * fq;
        const bool isqk = (p3 != 2), isq = (p3 == 0), dorope = (part >= 3) && isqk;
        const float* g = gn + part * 64;
        f32x4 gv[2][2];
#pragma unroll
        for (int bj = 0; bj < 2; ++bj)
#pragma unroll
            for (int n = 0; n < 2; ++n) gv[bj][n] = *(const f32x4*)(g + 32 * bj + 8 * fq + 4 * n);
        float rsx[2][4]; row_rstd(SS, u.pm * BM + wr * 64 + fr, fq, rsx);
#pragma unroll
        for (int ai = 0; ai < 2; ++ai)
#pragma unroll
            for (int m = 0; m < 4; ++m) {
                const int row = u.pm * BM + ai * HALF + wr * 64 + m * 16 + fr;
                f32x4 v[2][2];
#pragma unroll
                for (int bj = 0; bj < 2; ++bj)
#pragma unroll
                    for (int n = 0; n < 2; ++n) v[bj][n] = acc[ai][bj][m][n] * rsx[ai][m];
                if (isqk) {
                    float ss = 0.f;
#pragma unroll
                    for (int bj = 0; bj < 2; ++bj)
#pragma unroll
                        for (int n = 0; n < 2; ++n) ss += (v[bj][n][0] * v[bj][n][0] + v[bj][n][1] * v[bj][n][1]) + (v[bj][n][2] * v[bj][n][2] + v[bj][n][3] * v[bj][n][3]);
                    ss += __shfl_xor(ss, 16); ss += __shfl_xor(ss, 32);
                    const float rs = 1.0f / sqrtf(ss * (1.0f / 64.0f) + 1e-6f);
#pragma unroll
                    for (int bj = 0; bj < 2; ++bj)
#pragma unroll
                        for (int n = 0; n < 2; ++n) v[bj][n] = v[bj][n] * rs * gv[bj][n];
                    if (dorope) {
                        const int pos = (row < 16384) ? row : ((row - 16384) & 4095);
                        const float* cs = rope + (size_t)pos * 16;
#pragma unroll
                        for (int n = 0; n < 2; ++n) {
                            const f32x4 c = *(const f32x4*)(cs + 4 * n), s = *(const f32x4*)(cs + 8 + 4 * n);
                            const f32x4 me = v[0][n]; f32x4 ot;
#pragma unroll
                            for (int i = 0; i < 4; ++i) ot[i] = __shfl_xor(me[i], 16);
                            const f32x4 r0 = me * c - ot * s, r1 = me * c + ot * s;
                            if (fq == 0) v[0][n] = r0; else if (fq == 1) v[0][n] = r1;
                        }
                    }
                    if (isq) {
#pragma unroll
                        for (int bj = 0; bj < 2; ++bj)
#pragma unroll
                            for (int n = 0; n < 2; ++n) v[bj][n] = v[bj][n] * QSCALE_;
                    }
                }
                bf16_t* rowp = dst + (size_t)row * LDQKV_ + pcol;
#pragma unroll
                for (int bj = 0; bj < 2; ++bj) *(u32x4*)(rowp + 32 * bj) = pack8(v[bj][0], v[bj][1]);
            }
    }
};
struct EpiY {
    static constexpr bool PERM = true, AFTER_DRAIN = false, MID = false;
    bf16_t* Y;
    __device__ __forceinline__ void operator()(const f32x4 (&acc)[2][2][4][2], const Unit& u, int wr, int wc, int fr, int fq) const {
        const int row0 = u.pm * BM + wr * 64 + fr, col0 = u.pn * BM + wc * 32 + 8 * fq;
#pragma unroll
        for (int ai = 0; ai < 2; ++ai)
#pragma unroll
            for (int m = 0; m < 4; ++m) {
                bf16_t* rowp = Y + (size_t)(row0 + ai * HALF + m * 16) * LDG_ + col0;
#pragma unroll
                for (int bj = 0; bj < 2; ++bj) *(u32x4*)(rowp + bj * HALF) = pack8(acc[ai][bj][m][0], acc[ai][bj][m][1]);
            }
    }
};
struct EpiGateMerge {
    static constexpr bool PERM = true, AFTER_DRAIN = false, MID = false;
    const bf16_t* Y; bf16_t* MG; const float* SS;
    __device__ __forceinline__ void operator()(const f32x4 (&acc)[2][2][4][2], const Unit& u, int wr, int wc, int fr, int fq) const {
        const int row0 = u.pm * BM + wr * 64 + fr, col0 = u.pn * 128 + wc * 32 + 8 * fq;
        float rs[2][4]; row_rstd(SS, row0, fq, rs);
#pragma unroll
        for (int ai = 0; ai < 2; ++ai) {
            u32x4 ya[4], yb[4];
#pragma unroll
            for (int m = 0; m < 4; ++m) { const bf16_t* yp = Y + (size_t)(row0 + ai * HALF + m * 16) * LDG_ + col0; ya[m] = *(const u32x4*)yp; yb[m] = *(const u32x4*)(yp + 1024); }
#pragma unroll
            for (int m = 0; m < 4; ++m) {
                f32x4 v[2];
#pragma unroll
                for (int w = 0; w < 4; ++w) {
                    const int n = w >> 1, i0 = (w & 1) * 2;
                    v[n][i0]     = sigm(acc[ai][0][m][n][i0]     * rs[ai][m]) * bf_lo(ya[m][w]) + sigm(acc[ai][1][m][n][i0]     * rs[ai][m]) * bf_lo(yb[m][w]);
                    v[n][i0 + 1] = sigm(acc[ai][0][m][n][i0 + 1] * rs[ai][m]) * bf_hi(ya[m][w]) + sigm(acc[ai][1][m][n][i0 + 1] * rs[ai][m]) * bf_hi(yb[m][w]);
                }
                *(u32x4*)(MG + (size_t)(row0 + ai * HALF + m * 16) * DM_ + col0) = pack8(v[0], v[1]);
            }
            asm volatile("" ::: "memory");
        }
    }
};
template <class Epi, class Sched, bool ALIGN_EPI = false, bool SP2 = false>
__device__ __forceinline__ void gemm_phase(PG8_LAS unsigned char* lds, const Gemm g, const Sched& S, const Epi& E) {
    int tid_ = threadIdx.x; asm volatile("" : "+v"(tid_));
    const int tid = tid_, wid = __builtin_amdgcn_readfirstlane(tid >> 6), lane = tid & 63, wr = wid >> 2, wc = wid & 3, fr = lane & 15, fq = lane >> 4;
    const int K = g.K, nt = K / BK, lda = g.lda ? g.lda : g.K;
    unsigned voffA[2], voffB[2];
#pragma unroll
    for (int i = 0; i < 2; ++i) { int R, C; stage_rc(tid * 16 + i * 8192, R, C); const int Rb = Epi::PERM ? ((R & ~31) + perm32(R & 31)) : R;
        voffA[i] = (unsigned)(R * lda + C) * 2u; voffB[i] = (unsigned)(Rb * K + C) * 2u; }
    const size_t kstep = (size_t)(BK * 2);
    const size_t hstep = (size_t)HALF * K * 2;
    const size_t tstep = 2 * hstep;
    const size_t hstepA = (size_t)HALF * lda * 2, tstepA = 2 * hstepA;
    const unsigned ldsw = (unsigned)wid * 1024u;
    const int aoff = lds_byte(wr * 64 + fr, fq * 8), boff = lds_byte(wc * 32 + fr, fq * 8);
#define PG8_SA(b, h) (((b) * 2 + (h)) * HTB)
#define PG8_SB(b, h) ((4 + (b) * 2 + (h)) * HTB)
#define PG8_STAGE(bufoff, gbase, voff) do { _Pragma("unroll") for (int _i = 0; _i < 2; ++_i) \
        __builtin_amdgcn_global_load_lds((const unsigned*)((const char*)(gbase) + (voff)[_i]), (PG8_LAS unsigned*)(lds + (bufoff) + ldsw + _i * 8192), 16, 0, 0); } while (0)
#define PG8_LDA(dst, b, h) do { _Pragma("unroll") for (int m = 0; m < 4; ++m) _Pragma("unroll") for (int k = 0; k < 2; ++k) dst[m][k] = *(const PG8_LAS bf16x8*)(lds + PG8_SA(b, h) + aoff + m * 2048 + k * 1024); } while (0)
#define PG8_LDB(dst, b, h) do { _Pragma("unroll") for (int n = 0; n < 2; ++n) _Pragma("unroll") for (int k = 0; k < 2; ++k) dst[n][k] = *(const PG8_LAS bf16x8*)(lds + PG8_SB(b, h) + boff + n * 2048 + k * 1024); } while (0)
#define PG8_MMA(ai, bj, At, Bt) do { __builtin_amdgcn_s_setprio(1); _Pragma("unroll") for (int m = 0; m < 4; ++m) _Pragma("unroll") for (int n = 0; n < 2; ++n) _Pragma("unroll") for (int k = 0; k < 2; ++k) \
        acc[ai][bj][m][n] = __builtin_amdgcn_mfma_f32_16x16x32_bf16(Bt[n][k], At[m][k], acc[ai][bj][m][n], 0, 0, 0); __builtin_amdgcn_s_setprio(0); } while (0)
#define PG8_WAIT_V(n) asm volatile("s_waitcnt vmcnt(" #n ")" ::: "memory")
#define PG8_WAIT_L(n) asm volatile("s_waitcnt lgkmcnt(" #n ")" ::: "memory")
#define PG8_BAR __builtin_amdgcn_s_barrier()
#define PG8_SCHED __builtin_amdgcn_sched_barrier(0)
    Unit cur, nxt; int ui = 0;
    if (!S.next(0, cur)) return;
    f32x4 acc[2][2][4][2];
#pragma unroll
    for (int a = 0; a < 2; ++a)
#pragma unroll
        for (int b = 0; b < 2; ++b)
#pragma unroll
            for (int m = 0; m < 4; ++m)
#pragma unroll
                for (int n = 0; n < 2; ++n) acc[a][b][m][n] = (f32x4){0.f, 0.f, 0.f, 0.f};
    bf16x8 At[4][2], B0[2][2], B1[2][2];
    const char* cA = (const char*)g.A + (size_t)cur.pm * tstepA + (size_t)(cur.pn >> 2) * g.aselb; const char* cB = (const char*)g.Bt + (size_t)cur.pn * tstep;
    S.a_ready(cur);
    if constexpr (SP2) {
        PG8_STAGE(PG8_SB(0, 0), cB, voffB); PG8_STAGE(PG8_SB(0, 1), cB + hstep, voffB); PG8_STAGE(PG8_SA(0, 0), cA, voffA); PG8_STAGE(PG8_SA(0, 1), cA + hstepA, voffA);
        if (wr == 1) PG8_BAR;
        PG8_WAIT_V(2); PG8_BAR;
        PG8_STAGE(PG8_SB(1, 0), cB + kstep, voffB); PG8_STAGE(PG8_SA(1, 0), cA + kstep, voffA); PG8_STAGE(PG8_SB(1, 1), cB + hstep + kstep, voffB);
        PG8_WAIT_V(6); PG8_BAR;
    } else {
        PG8_STAGE(PG8_SB(0, 0), cB, voffB); PG8_STAGE(PG8_SA(0, 0), cA, voffA); PG8_STAGE(PG8_SB(0, 1), cB + hstep, voffB); PG8_STAGE(PG8_SA(0, 1), cA + hstepA, voffA);
        if (wr == 1) PG8_BAR;
        PG8_WAIT_V(4); PG8_BAR;
        PG8_STAGE(PG8_SB(1, 0), cB + kstep, voffB); PG8_STAGE(PG8_SA(1, 0), cA + kstep, voffA); PG8_STAGE(PG8_SB(1, 1), cB + hstep + kstep, voffB);
        PG8_WAIT_V(6); PG8_BAR;
    }
    for (;;) {
        const bool has_next = S.next(ui + 1, nxt);
        const char* nA = has_next ? (const char*)g.A + (size_t)nxt.pm * tstepA + (size_t)(nxt.pn >> 2) * g.aselb : cA; const char* nB = has_next ? (const char*)g.Bt + (size_t)nxt.pn * tstep : cB;
        for (int t = 0; t < nt; t += 2) {
            if constexpr (Epi::MID) { if (t == (nt >> 1)) E.mid(acc, cur, wr, wc, fr, fq); }
            const bool last = (t == nt - 2);
            const char* a1 = cA + (size_t)(t + 1) * kstep;
            const char* a2 = last ? nA : cA + (size_t)(t + 2) * kstep; const char* b2 = last ? nB : cB + (size_t)(t + 2) * kstep;
            const char* a3 = a2 + kstep; const char* b3 = b2 + kstep;
            if (last && has_next) S.a_ready(nxt);
            if constexpr (SP2) {
            PG8_LDB(B0, 0, 0); PG8_LDB(B1, 0, 1); PG8_SCHED; PG8_LDA(At, 0, 0); PG8_STAGE(PG8_SA(1, 1), a1 + hstepA, voffA);
            PG8_WAIT_V(8); PG8_WAIT_L(0); PG8_BAR; PG8_MMA(0, 0, At, B0); PG8_MMA(0, 1, At, B1); PG8_BAR; PG8_SCHED;
            PG8_LDA(At, 0, 1); PG8_STAGE(PG8_SB(0, 0), b2, voffB); PG8_STAGE(PG8_SB(0, 1), b2 + hstep, voffB); PG8_STAGE(PG8_SA(0, 0), a2, voffA);
            PG8_WAIT_V(8); PG8_WAIT_L(0); PG8_BAR; PG8_MMA(1, 0, At, B0); PG8_MMA(1, 1, At, B1); PG8_BAR; PG8_SCHED;
            PG8_LDB(B0, 1, 0); PG8_LDB(B1, 1, 1); PG8_SCHED; PG8_LDA(At, 1, 0); PG8_STAGE(PG8_SA(0, 1), a2 + hstepA, voffA);
            PG8_WAIT_V(8); PG8_WAIT_L(0); PG8_BAR; PG8_MMA(0, 0, At, B0); PG8_MMA(0, 1, At, B1); PG8_BAR; PG8_SCHED;
            PG8_LDA(At, 1, 1); PG8_STAGE(PG8_SB(1, 0), b3, voffB); PG8_STAGE(PG8_SB(1, 1), b3 + hstep, voffB); PG8_STAGE(PG8_SA(1, 0), a3, voffA);
            PG8_WAIT_V(8); PG8_WAIT_L(0); PG8_BAR; PG8_MMA(1, 0, At, B0); PG8_MMA(1, 1, At, B1); PG8_BAR; PG8_SCHED;
            } else {
            PG8_LDB(B0, 0, 0); PG8_SCHED; PG8_LDA(At, 0, 0); PG8_STAGE(PG8_SA(1, 1), a1 + hstepA, voffA);
            PG8_WAIT_L(8); PG8_BAR; PG8_WAIT_L(0); PG8_MMA(0, 0, At, B0); PG8_BAR; PG8_SCHED;
            PG8_LDB(B1, 0, 1); PG8_STAGE(PG8_SB(0, 0), b2, voffB);
            PG8_BAR; PG8_WAIT_L(0); PG8_MMA(0, 1, At, B1); PG8_BAR;
            PG8_LDA(At, 0, 1); PG8_STAGE(PG8_SA(0, 0), a2, voffA);
            PG8_BAR; PG8_WAIT_L(0); PG8_MMA(1, 0, At, B0); PG8_BAR; PG8_SCHED;
            PG8_STAGE(PG8_SB(0, 1), b2 + hstep, voffB);
            PG8_WAIT_V(6); PG8_BAR; PG8_MMA(1, 1, At, B1); PG8_BAR;
            PG8_LDB(B0, 1, 0); PG8_SCHED; PG8_LDA(At, 1, 0); PG8_STAGE(PG8_SA(0, 1), a2 + hstepA, voffA);
            PG8_WAIT_L(8); PG8_BAR; PG8_WAIT_L(0); PG8_MMA(0, 0, At, B0); PG8_BAR; PG8_SCHED;
            PG8_LDB(B1, 1, 1); PG8_STAGE(PG8_SB(1, 0), b3, voffB);
            PG8_BAR; PG8_WAIT_L(0); PG8_MMA(0, 1, At, B1); PG8_BAR;
            PG8_LDA(At, 1, 1); PG8_STAGE(PG8_SA(1, 0), a3, voffA);
            PG8_BAR; PG8_WAIT_L(0); PG8_MMA(1, 0, At, B0); PG8_BAR; PG8_SCHED;
            PG8_STAGE(PG8_SB(1, 1), b3 + hstep, voffB);
            PG8_WAIT_V(6); PG8_BAR; PG8_MMA(1, 1, At, B1); PG8_BAR;
            }
        }
        if constexpr (ALIGN_EPI) { if (wr == 0) PG8_BAR; }
        if constexpr (!Epi::AFTER_DRAIN) { E(acc, cur, wr, wc, fr, fq); S.done(cur); }
        if (!has_next) break;
#pragma unroll
        for (int a = 0; a < 2; ++a)
#pragma unroll
            for (int b = 0; b < 2; ++b)
#pragma unroll
                for (int m = 0; m < 4; ++m)
#pragma unroll
                    for (int n = 0; n < 2; ++n) acc[a][b][m][n] = (f32x4){0.f, 0.f, 0.f, 0.f};
        cur = nxt; cA = nA; cB = nB; ++ui;
        if constexpr (ALIGN_EPI) { if (wr == 1) PG8_BAR; }
    }
    PG8_WAIT_V(0);
    if constexpr (!ALIGN_EPI) { if (wr == 0) PG8_BAR; }
    PG8_BAR;
    if constexpr (Epi::AFTER_DRAIN) { E.fused(acc, cur, wr, wc, fr, fq, lds, wid, lane); S.done(cur); }
#undef PG8_SA
#undef PG8_SB
#undef PG8_STAGE
#undef PG8_LDA
#undef PG8_LDB
#undef PG8_MMA
#undef PG8_WAIT_V
#undef PG8_WAIT_L
#undef PG8_BAR
#undef PG8_SCHED
}
}
namespace att {
#define ALAS __attribute__((address_space(3)))
typedef unsigned short bf16_t;
using bf16x8 = __attribute__((ext_vector_type(8))) short;
using s16x4  = __attribute__((ext_vector_type(4))) short;
using f32x16 = __attribute__((ext_vector_type(16))) float;
using u32x4  = __attribute__((ext_vector_type(4))) unsigned;
constexpr int LD = 1536;
constexpr int SHM_K = 8192, SHM_V = 16384;
constexpr int L_V = 0, L_K = 2 * SHM_V, L_WS = L_K + 2 * SHM_K, L_TAB = L_WS + 2048, L_STASH = L_TAB + 2048, L_END = L_STASH + 65536;
constexpr float THR2 = 8.f;
#define KSWZ(row, colB) ((row) * 128 + ((colB) ^ ((((row) >> 1) & 7) << 4)))
#define SBAR() __builtin_amdgcn_sched_barrier(0)
__device__ __forceinline__ int crow(int r, int hi) { return (r & 3) + 8 * (r >> 2) + 4 * hi; }
typedef float f32x2c_ __attribute__((ext_vector_type(2))); typedef __bf16 bf16x2c_ __attribute__((ext_vector_type(2)));
__device__ __forceinline__ unsigned cvtpk(float lo, float hi) { f32x2c_ v = {lo, hi}; bf16x2c_ b = __builtin_convertvector(v, bf16x2c_); return __builtin_bit_cast(unsigned, b); }

struct NaCtx { int klo, rq, s0q, qc, wstart; const ALAS float* tab; };
__device__ __forceinline__ void na_bias(f32x16& p0, f32x16& p1, int t, int hi, const NaCtx& c) {
  const int kr = c.klo + t; const bool active = (kr >= c.s0q) && (kr <= c.s0q + 7);
  if (!active) {
#pragma unroll
    for (int r = 0; r < 16; ++r) { p0[r] = -1e30f; p1[r] = -1e30f; }
    return;
  }
  const int tb = (kr - c.rq + 7) * 32 + 15 - c.qc;
#pragma unroll
  for (int r = 0; r < 16; ++r) {
    const int kc = crow(r, hi);
    { const bool v = (unsigned)(kc - c.wstart) < 16u; const float b = c.tab[v ? tb + kc : 0]; p0[r] = v ? p0[r] + b : -1e30f; }
    { const int k2 = kc + 32; const bool v = (unsigned)(k2 - c.wstart) < 16u; const float b = c.tab[v ? tb + k2 : 0]; p1[r] = v ? p1[r] + b : -1e30f; }
  }
}
__device__ __forceinline__ void k_issue(bf16x8 (&kf)[8], const ALAS char* Ks, int r32, int hi) {
#pragma unroll
  for (int d0 = 0; d0 < 4; ++d0) { const int cb = (d0 * 16 + hi * 8) * 2;
    kf[2 * d0] = *(const ALAS bf16x8*)(Ks + KSWZ(r32, cb)); kf[2 * d0 + 1] = *(const ALAS bf16x8*)(Ks + KSWZ(32 + r32, cb)); }
}
__device__ __forceinline__ void qkt(f32x16& p0, f32x16& p1, const bf16x8 (&kf)[8], const bf16x8* qr, const f32x16& cinit) {
  p0 = __builtin_amdgcn_mfma_f32_32x32x16_bf16(kf[0], qr[0], cinit, 0, 0, 0); p1 = __builtin_amdgcn_mfma_f32_32x32x16_bf16(kf[1], qr[0], cinit, 0, 0, 0);
#pragma unroll
  for (int d0 = 1; d0 < 4; ++d0) { p0 = __builtin_amdgcn_mfma_f32_32x32x16_bf16(kf[2 * d0], qr[d0], p0, 0, 0, 0); p1 = __builtin_amdgcn_mfma_f32_32x32x16_bf16(kf[2 * d0 + 1], qr[d0], p1, 0, 0, 0); }
}
template <int NC> __device__ __forceinline__ int v_st(int k, int c) { const int kk = (k & ~0xC) | ((k & 4) << 1) | ((k & 8) >> 1); return ((kk >> 3) * NC + (c >> 5)) * 512 + ((kk & 7) * 32 + (c & 31)) * 2; }
__device__ __forceinline__ int v_rd_base(int lane) { return ((lane & 3) << 3) | (((lane >> 2) & 3) << 6) | (((lane >> 4) & 1) << 5) | (((lane >> 5) & 1) << 8); }
template <int NC> constexpr int v_rd_off(int d0, int ks, int half) { return d0 * 512 + (2 * ks + half) * NC * 512; }
template <int OFF> __device__ __forceinline__ s16x4 tr_read(int vb) {
  s16x4 r; asm volatile("ds_read_b64_tr_b16 %0, %1 offset:%2" : "=&v"(r) : "v"(vb), "i"(OFF) : "memory"); return r;
}
template <int NC, int KS> __device__ __forceinline__ void v_issue_k(s16x4 (&L)[8], int vb) {
  L[0] = tr_read<v_rd_off<NC>(0, KS, 0)>(vb); L[1] = tr_read<v_rd_off<NC>(0, KS, 1)>(vb); L[2] = tr_read<v_rd_off<NC>(1, KS, 0)>(vb); L[3] = tr_read<v_rd_off<NC>(1, KS, 1)>(vb);
  if constexpr (NC == 4) { L[4] = tr_read<v_rd_off<NC>(2, KS, 0)>(vb); L[5] = tr_read<v_rd_off<NC>(2, KS, 1)>(vb); L[6] = tr_read<v_rd_off<NC>(3, KS, 0)>(vb); L[7] = tr_read<v_rd_off<NC>(3, KS, 1)>(vb); }
}
template <int NC> __device__ __forceinline__ void v_mma_k(f32x16* o, f32x16& osum, const s16x4 (&L)[8], bf16x8 pa, bf16x8 ones) {
#define PK(A, B) (bf16x8){A[0], A[1], A[2], A[3], B[0], B[1], B[2], B[3]}
  osum = __builtin_amdgcn_mfma_f32_32x32x16_bf16(pa, ones, osum, 0, 0, 0);
  o[0] = __builtin_amdgcn_mfma_f32_32x32x16_bf16(pa, PK(L[0], L[1]), o[0], 0, 0, 0);
  o[1] = __builtin_amdgcn_mfma_f32_32x32x16_bf16(pa, PK(L[2], L[3]), o[1], 0, 0, 0);
  if constexpr (NC == 4) { o[2] = __builtin_amdgcn_mfma_f32_32x32x16_bf16(pa, PK(L[4], L[5]), o[2], 0, 0, 0); o[3] = __builtin_amdgcn_mfma_f32_32x32x16_bf16(pa, PK(L[6], L[7]), o[3], 0, 0, 0); }
#undef PK
}
template <int DV, bool NA>
__device__ __forceinline__ void attn_core(const bf16_t* __restrict__ Qlane, const bf16_t* __restrict__ Kh, const bf16_t* __restrict__ Vh, const int NT,
                                          ALAS char* lds, f32x16 (&o)[DV / 32], const NaCtx& na) {
  constexpr int NC = DV / 32;
  int tid_ = threadIdx.x; asm volatile("" : "+v"(tid_));
  const int tid = tid_, wid = __builtin_amdgcn_readfirstlane(tid >> 6), lane = tid & 63, r32 = lane & 31, hi = lane >> 5;
  ALAS char* V_lds = lds + L_V; ALAS char* K_lds = lds + L_K;
  ALAS float* al_l = (ALAS float*)(lds + L_WS) + wid * 64;
  float m_ref = 0.f;
  f32x16 osum = f32x16{}, negm = f32x16{};
#pragma unroll
  for (int d = 0; d < NC; ++d) o[d] = f32x16{};
  bf16x8 qr[4];
#pragma unroll
  for (int d0 = 0; d0 < 4; ++d0) qr[d0] = *reinterpret_cast<const bf16x8*>(Qlane + d0 * 16);
  const bf16x8 ones = {0x3f80, 0x3f80, 0x3f80, 0x3f80, 0x3f80, 0x3f80, 0x3f80, 0x3f80};
  const int kr_ = tid >> 3, kc8 = (tid & 7) * 8, kst = KSWZ(kr_, kc8 * 2);
  const int vr_ = (DV == 128) ? (tid >> 4) : (tid >> 3), vc8 = (DV == 128) ? (tid & 15) * 8 : (tid & 7) * 8;
  const int vst0 = v_st<NC>(vr_, vc8), vst1 = v_st<NC>((32 + vr_) & 63, vc8);
  const int vb0 = (int)(uintptr_t)V_lds + v_rd_base(lane);
  const int kgo = kr_ * LD + kc8, vgo = vr_ * LD + vc8;
  bf16x8 sk0, sva0, svb0, sk1, sva1, svb1;
#define SLOADX(S, k0) do { sk##S = *reinterpret_cast<const bf16x8*>(Kh + (long)(k0) * LD + kgo); sva##S = *reinterpret_cast<const bf16x8*>(Vh + (long)(k0) * LD + vgo); \
    if constexpr (DV == 128) svb##S = *reinterpret_cast<const bf16x8*>(Vh + (long)((k0) + 32) * LD + vgo); } while (0)
#define SWRITEX(S, b) do { *(ALAS bf16x8*)(V_lds + (b) * SHM_V + vst0) = sva##S; if constexpr (DV == 128) *(ALAS bf16x8*)(V_lds + (b) * SHM_V + vst1) = svb##S; \
    *(ALAS bf16x8*)(K_lds + (b) * SHM_K + kst) = sk##S; } while (0)
#define ACT(t) (!NA || ((na.klo + (t)) >= na.s0q && (na.klo + (t)) <= na.s0q + 7))
  SLOADX(0, 0); asm volatile("s_waitcnt vmcnt(0)" ::: "memory"); SWRITEX(0, 0); SLOADX(1, 64); SLOADX(0, 128); __syncthreads();
  for (int jj = 0; jj < NT; jj += 2) {
#pragma unroll
   for (int par = 0; par < 2; ++par) {
    const int j = jj + par; const int b = par; const bool act = ACT(j);
    bf16x8 kf[8];
    if (act) k_issue(kf, K_lds + b * SHM_K, r32, hi);
    if (par == 0) { if (j + 1 < NT) { SWRITEX(1, 1); if (j + 3 < NT) SLOADX(1, (j + 3) * 64); } }
    else          { if (j + 1 < NT) { SWRITEX(0, 0); if (j + 3 < NT) SLOADX(0, (j + 3) * 64); } }
    if (act) {
      f32x16 p0, p1;
      qkt(p0, p1, kf, qr, negm);
      if constexpr (NA) na_bias(p0, p1, j, hi, na);
      float pmax = fmaxf(p0[0], p1[0]), pmx2 = fmaxf(p0[1], p1[1]);
#pragma unroll
      for (int r = 2; r < 16; r += 2) { pmax = __builtin_fmaxf(__builtin_fmaxf(pmax, p0[r]), p1[r]); pmx2 = __builtin_fmaxf(__builtin_fmaxf(pmx2, p0[r + 1]), p1[r + 1]); }
      pmax = fmaxf(pmax, pmx2);
      { auto rr = __builtin_amdgcn_permlane32_swap(__float_as_uint(pmax), __float_as_uint(pmax), false, false);
        pmax = fmaxf(__uint_as_float(rr[0]), __uint_as_float(rr[1])); }
      if (__builtin_expect(!__all(pmax <= THR2), 0)) {
        const float dl = fmaxf(pmax, 0.f); m_ref += dl;
#pragma unroll
        for (int r = 0; r < 16; ++r) { p0[r] -= dl; p1[r] -= dl; negm[r] = -m_ref; }
        const float f = __builtin_amdgcn_exp2f(-dl);
        if (hi == 0) al_l[r32] = f; asm volatile("s_waitcnt lgkmcnt(0)" ::: "memory");
#pragma unroll
        for (int r = 0; r < 16; ++r) { const float ar = al_l[crow(r, hi)]; osum[r] *= ar;
#pragma unroll
          for (int d = 0; d < NC; ++d) o[d][r] *= ar; }
      }
      const int vb = vb0 + b * SHM_V;
      s16x4 LA[8], LB[8]; bf16x8 pa;
#define PK4(P, BASE, OUT) do { unsigned a0 = cvtpk(P[BASE + 0], P[BASE + 1]), a1 = cvtpk(P[BASE + 2], P[BASE + 3]);   \
    unsigned b0 = cvtpk(P[BASE + 4], P[BASE + 5]), b1 = cvtpk(P[BASE + 6], P[BASE + 7]);                              \
    auto r0 = __builtin_amdgcn_permlane32_swap(a0, b0, false, false); auto r1 = __builtin_amdgcn_permlane32_swap(a1, b1, false, false); \
    u32x4 w = {r0[0], r1[0], r0[1], r1[1]}; OUT = *reinterpret_cast<bf16x8*>(&w); } while (0)
#define EXP8(P, BASE) do { _Pragma("unroll") for (int r = 0; r < 8; ++r) P[BASE + r] = __builtin_amdgcn_exp2f(P[BASE + r]); } while (0)
#define LGKM(n) asm volatile("s_waitcnt lgkmcnt(" #n ")" ::: "memory")
      v_issue_k<NC, 0>(LA, vb);
      EXP8(p0, 0); PK4(p0, 0, pa); SBAR();
      v_issue_k<NC, 1>(LB, vb); if constexpr (NC == 4) LGKM(8); else LGKM(4); SBAR(); v_mma_k<NC>(o, osum, LA, pa, ones); SBAR();
      EXP8(p0, 8); PK4(p0, 8, pa); SBAR();
      v_issue_k<NC, 2>(LA, vb); if constexpr (NC == 4) LGKM(8); else LGKM(4); SBAR(); v_mma_k<NC>(o, osum, LB, pa, ones); SBAR();
      EXP8(p1, 0); PK4(p1, 0, pa); SBAR();
      v_issue_k<NC, 3>(LB, vb); if constexpr (NC == 4) LGKM(8); else LGKM(4); SBAR(); v_mma_k<NC>(o, osum, LA, pa, ones); SBAR();
      EXP8(p1, 8); PK4(p1, 8, pa); SBAR();
      LGKM(0); SBAR(); v_mma_k<NC>(o, osum, LB, pa, ones);
#undef PK4
#undef EXP8
#undef LGKM
    }
    __syncthreads();
   }
  }
#pragma unroll
  for (int r = 0; r < 16; ++r) { const float rl = __builtin_amdgcn_rcpf(osum[r]);
#pragma unroll
    for (int d = 0; d < NC; ++d) o[d][r] *= rl; }
#undef SLOADX
#undef SWRITEX
#undef ACT
}
__device__ __forceinline__ bf16_t to_bf16(float v) { return (bf16_t)(cvtpk(v, 0.f) & 0xffffu); }

constexpr int NAW_V = 0, NAW_TAB = 131072, NAW_TSTRIDE = 2000, NAW_END = NAW_TAB + 8 * NAW_TSTRIDE;
__device__ __forceinline__ void na_wave_units(int gw, int NGW, const bf16_t* QA, bf16_t* AB, const float* rpb  , ALAS char* lds) {
  int tid_ = threadIdx.x; asm volatile("" : "+v"(tid_));
  const int tid = tid_, wid = __builtin_amdgcn_readfirstlane(tid >> 6), lane = tid & 63, r32 = lane & 31, hi = lane >> 5;
  const int h = gw & 7;
  ALAS char* Vw = lds + NAW_V + wid * 16384;
  ALAS float* tab = (ALAS float*)(lds + NAW_TAB + wid * NAW_TSTRIDE);
  for (int i = lane; i < 480; i += 64) { const int dr = i >> 5, dc = i & 31; tab[i] = (dc < 31) ? rpb[(h * 15 + dr) * 31 + dc] * 1.4426950408889634f : 0.f; }
  asm volatile("s_waitcnt lgkmcnt(0)" ::: "memory");
  const bf16x8 ones = {0x3f80, 0x3f80, 0x3f80, 0x3f80, 0x3f80, 0x3f80, 0x3f80, 0x3f80};
  const int vb0 = (int)(uintptr_t)Vw + v_rd_base(lane);
  int vgo[8], vso[8];
#pragma unroll
  for (int i = 0; i < 8; ++i) { const int p = i * 64 + lane, key = p >> 3, c8 = (p & 7) * 8; vgo[i] = key * LD + c8; vso[i] = v_st<2>(key, c8); }
  const int kgo0 = r32 * LD + hi * 8, kgo1 = (32 + r32) * LD + hi * 8;
  for (int wu = gw; wu < 20480; wu += NGW) {
    const int hf = (wu >> 3) & 1, rowg = wu >> 4;
    int base, r, rows;
    if (rowg < 256) { base = 0; r = rowg; rows = 256; } else { const int l = rowg - 256; base = 16384 + (l >> 6) * 4096; r = l & 63; rows = 64; }
    NaCtx c; c.s0q = min(max(r - 4, 0), rows - 8); c.klo = c.s0q; c.rq = r; c.qc = 32 * hf + r32; c.wstart = min(max(c.qc - 8, 0), 48); c.tab = tab;
    const long qrow = (long)base + r * 64 + hf * 32;
    const bf16_t* Qlane = QA + (qrow + r32) * LD + h * 64 + hi * 8;
    const bf16_t* Kb = QA + ((long)base + c.klo * 64) * LD + 512 + h * 64;
    const bf16_t* Vb = QA + ((long)base + c.klo * 64) * LD + 1024 + h * 64;
    bf16x8 qr[4];
#pragma unroll
    for (int d0 = 0; d0 < 4; ++d0) qr[d0] = *reinterpret_cast<const bf16x8*>(Qlane + d0 * 16);
    float m_ref = 0.f; f32x16 osum = f32x16{}, negm = f32x16{}, o[2]; o[0] = f32x16{}; o[1] = f32x16{};
    bf16x8 kf[8], vN[8];
#define KLOAD(t) do { _Pragma("unroll") for (int d0 = 0; d0 < 4; ++d0) { kf[2 * d0] = *reinterpret_cast<const bf16x8*>(Kb + (long)(t) * 64 * LD + kgo0 + d0 * 16); \
                                                                        kf[2 * d0 + 1] = *reinterpret_cast<const bf16x8*>(Kb + (long)(t) * 64 * LD + kgo1 + d0 * 16); } } while (0)
#define VLOAD(t) do { _Pragma("unroll") for (int i = 0; i < 8; ++i) vN[i] = *reinterpret_cast<const bf16x8*>(Vb + (long)(t) * 64 * LD + vgo[i]); } while (0)
#define VWRITE(b) do { _Pragma("unroll") for (int i = 0; i < 8; ++i) *(ALAS bf16x8*)(Vw + (b) * 8192 + vso[i]) = vN[i]; } while (0)
    KLOAD(0); VLOAD(0); VWRITE(0);
#pragma unroll
    for (int t = 0; t < 8; ++t) {
      const int b = t & 1;
      if (t + 1 < 8) VLOAD(t + 1);
      f32x16 p0, p1;
      qkt(p0, p1, kf, qr, negm);
      if (t + 1 < 8) { asm volatile("" ::: "memory"); KLOAD(t + 1); }
      na_bias(p0, p1, t, hi, c);
      float pmax = fmaxf(p0[0], p1[0]), pmx2 = fmaxf(p0[1], p1[1]);
#pragma unroll
      for (int q = 2; q < 16; q += 2) { pmax = __builtin_fmaxf(__builtin_fmaxf(pmax, p0[q]), p1[q]); pmx2 = __builtin_fmaxf(__builtin_fmaxf(pmx2, p0[q + 1]), p1[q + 1]); }
      pmax = fmaxf(pmax, pmx2);
      { auto rr = __builtin_amdgcn_permlane32_swap(__float_as_uint(pmax), __float_as_uint(pmax), false, false); pmax = fmaxf(__uint_as_float(rr[0]), __uint_as_float(rr[1])); }
      if (__builtin_expect(!__all(pmax <= THR2), 0)) {
        const float dl = fmaxf(pmax, 0.f); m_ref += dl;
#pragma unroll
        for (int q = 0; q < 16; ++q) { p0[q] -= dl; p1[q] -= dl; negm[q] = -m_ref; }
        const float f = __builtin_amdgcn_exp2f(-dl);
#pragma unroll
        for (int q = 0; q < 16; ++q) { const float ar = __shfl(f, crow(q, hi), 64); osum[q] *= ar; o[0][q] *= ar; o[1][q] *= ar; }
      }
#pragma unroll
      for (int q = 0; q < 16; ++q) { p0[q] = __builtin_amdgcn_exp2f(p0[q]); p1[q] = __builtin_amdgcn_exp2f(p1[q]); }
      bf16x8 pa0, pa1, pa2, pa3;
#define PK4(P, BASE, OUT) do { unsigned a0 = cvtpk(P[BASE + 0], P[BASE + 1]), a1 = cvtpk(P[BASE + 2], P[BASE + 3]);   \
    unsigned b0 = cvtpk(P[BASE + 4], P[BASE + 5]), b1 = cvtpk(P[BASE + 6], P[BASE + 7]);                              \
    auto r0 = __builtin_amdgcn_permlane32_swap(a0, b0, false, false); auto r1 = __builtin_amdgcn_permlane32_swap(a1, b1, false, false); \
    u32x4 w = {r0[0], r1[0], r0[1], r1[1]}; OUT = *reinterpret_cast<bf16x8*>(&w); } while (0)
      PK4(p0, 0, pa0); PK4(p0, 8, pa1); PK4(p1, 0, pa2); PK4(p1, 8, pa3);
#undef PK4
      { const int vb = vb0 + b * 8192; s16x4 LA[8], LB[8];
        v_issue_k<2, 0>(LA, vb); v_issue_k<2, 1>(LB, vb); asm volatile("s_waitcnt lgkmcnt(4)" ::: "memory"); SBAR(); v_mma_k<2>(o, osum, LA, pa0, ones); SBAR();
        v_issue_k<2, 2>(LA, vb); asm volatile("s_waitcnt lgkmcnt(4)" ::: "memory"); SBAR(); v_mma_k<2>(o, osum, LB, pa1, ones); SBAR();
        v_issue_k<2, 3>(LB, vb); asm volatile("s_waitcnt lgkmcnt(4)" ::: "memory"); SBAR(); v_mma_k<2>(o, osum, LA, pa2, ones); SBAR();
        asm volatile("s_waitcnt lgkmcnt(0)" ::: "memory"); SBAR(); v_mma_k<2>(o, osum, LB, pa3, ones); }
      if (t + 1 < 8) VWRITE(b ^ 1);
    }
#undef KLOAD
#undef VLOAD
#undef VWRITE
    bf16_t* Ow = AB + qrow * 1024 + h * 64 + r32;
#pragma unroll
    for (int q = 0; q < 16; ++q) { const float rl = __builtin_amdgcn_rcpf(osum[q]); const int orow = crow(q, hi);
      Ow[(long)orow * 1024] = to_bf16(o[0][q] * rl); Ow[(long)orow * 1024 + 32] = to_bf16(o[1][q] * rl); }
    asm volatile("s_waitcnt lgkmcnt(0)" ::: "memory");
  }
}
__device__ __forceinline__ void diff_unit(int base, int seq, int h, int qblk, const bf16_t* QB, bf16_t* AB, float lam, float one_m_li, const float* subln, ALAS char* lds) {
  int tid_ = threadIdx.x; asm volatile("" : "+v"(tid_));
  const int tid = tid_, wid = __builtin_amdgcn_readfirstlane(tid >> 6), lane = tid & 63, r32 = lane & 31, hi = lane >> 5;
  const int row0 = base + qblk * 256;
  ALAS unsigned* stash = (ALAS unsigned*)(lds + L_STASH) + wid * 2048;
  NaCtx c{};
  f32x16 o[4];
  for (int mp = 0; mp < 2; ++mp) {
    const bf16_t* Qlane = QB + (long)(row0 + wid * 32 + r32) * LD + h * 128 + mp * 64 + hi * 8;
    const bf16_t* Kh = QB + (long)base * LD + 512 + h * 128 + mp * 64;
    const bf16_t* Vh = QB + (long)base * LD + 1024 + h * 128;
    attn_core<128, false>(Qlane, Kh, Vh, seq >> 6, lds, o, c);
    if (mp == 0) {
#pragma unroll
      for (int d0 = 0; d0 < 4; ++d0)
#pragma unroll
        for (int r = 0; r < 16; r += 2) stash[(d0 * 8 + (r >> 1)) * 64 + lane] = cvtpk(o[d0][r], o[d0][r + 1]);
    }
  }
  asm volatile("s_waitcnt lgkmcnt(0)" ::: "memory");
  float sg[4];
#pragma unroll
  for (int d0 = 0; d0 < 4; ++d0) sg[d0] = subln[d0 * 32 + r32] * one_m_li;
  bf16_t* Ow = AB + (long)(row0 + wid * 32) * 1024 + 512 + h * 128 + r32;
#pragma unroll
  for (int r = 0; r < 16; r += 2) {
    float v0[4], v1[4]; float s0 = 0.f, s1 = 0.f;
#pragma unroll
    for (int d0 = 0; d0 < 4; ++d0) { const unsigned w = stash[(d0 * 8 + (r >> 1)) * 64 + lane];
      v0[d0] = __uint_as_float(w << 16) - lam * o[d0][r]; v1[d0] = __uint_as_float(w & 0xffff0000u) - lam * o[d0][r + 1];
      s0 += v0[d0] * v0[d0]; s1 += v1[d0] * v1[d0]; }
#pragma unroll
    for (int x = 1; x < 32; x <<= 1) { s0 += __shfl_xor(s0, x); s1 += __shfl_xor(s1, x); }
    const float rs0 = 1.0f / sqrtf(s0 * (1.0f / 128.0f) + 1e-5f), rs1 = 1.0f / sqrtf(s1 * (1.0f / 128.0f) + 1e-5f);
    const int or0 = crow(r, hi), or1 = crow(r + 1, hi);
#pragma unroll
    for (int d0 = 0; d0 < 4; ++d0) { Ow[(long)or0 * 1024 + d0 * 32] = to_bf16(v0[d0] * rs0 * sg[d0]); Ow[(long)or1 * 1024 + d0 * 32] = to_bf16(v1[d0] * rs1 * sg[d0]); }
  }
}
#undef SBAR
}
#define LAS __attribute__((address_space(3)))
typedef unsigned short bf16;
typedef unsigned v4u __attribute__((ext_vector_type(4)));
typedef unsigned v2u __attribute__((ext_vector_type(2)));
typedef float f32x4 __attribute__((ext_vector_type(4)));
constexpr int NWAVES = 8;
constexpr int MTOK = 81920, NP = 16384, DM = 1024, DFF = 2816, NLAYER = 2;
constexpr size_t MiB = 1u << 20;
constexpr size_t WS_GNH = 64 * 1024;
constexpr size_t WS_RPB = 128 * 1024, WS_SUB = 192 * 1024, WS_LAM = 200 * 1024;
constexpr size_t WS_ROPE = 1 * MiB;
constexpr size_t WS_W = 4 * MiB, WS_WL = 48 * MiB;
constexpr size_t WS_H = 104 * MiB;
constexpr size_t WS_R = 264 * MiB;
constexpr size_t WS_T = WS_R;
constexpr size_t WS_QA = WS_R, WS_QB = WS_R + 240 * MiB, WS_AB = WS_R + 480 * MiB;
constexpr size_t WS_G = WS_R, WS_MG = WS_R + 320 * MiB;
constexpr size_t WS_SS = WS_R + 640 * MiB;
constexpr size_t WS_END = WS_SS + 6 * MiB;
constexpr size_t WO_WI1 = 0, WO_WO1 = WO_WI1 + (size_t)5632 * 1024, WO_QKV = WO_WO1 + (size_t)1024 * 2816, WO_G = WO_QKV + (size_t)3072 * 1024,
                 WO_AB = WO_G + (size_t)2048 * 1024, WO_OUT = WO_AB + (size_t)1024 * 1024, WO_WI2 = WO_OUT + (size_t)1024 * 1024, WO_WO2 = WO_WI2 + (size_t)5632 * 1024,
                 WO_END = WO_WO2 + (size_t)1024 * 2816;
static_assert(WO_END * 2 <= WS_WL, "weight block");
constexpr int RING_BYTES = 131072, LDS_BYTES = 147456;
static_assert(att::L_END <= LDS_BYTES && att::NAW_END <= LDS_BYTES - 64, "attention LDS");

#define LDS_WAIT() asm volatile("s_waitcnt lgkmcnt(0)" ::: "memory")
__device__ __forceinline__ unsigned f2bf(float f) { unsigned u = __builtin_bit_cast(unsigned, f); return (u + 0x7fffu + ((u >> 16) & 1u)) >> 16; }
__device__ __forceinline__ unsigned pk2(float lo, float hi) { return f2bf(lo) | (f2bf(hi) << 16); }
__device__ __forceinline__ float wave_sum(float v) {
#pragma unroll
    for (int o = 1; o < 64; o <<= 1) v += __shfl_xor(v, o);
    return v;
}
__device__ __forceinline__ void tr_item(const float* W, int N, int k0, int n0, bf16* dst, int drow0, int ldd, int koff, LAS float* scr, int lane, const float* g = nullptr) {
    {   const int kr = lane >> 3, c4 = (lane & 7) * 4;
        f32x4 wv[8];
#pragma unroll
        for (int i = 0; i < 8; ++i) wv[i] = *(const f32x4*)(W + (size_t)(k0 + i * 8 + kr) * N + n0 + c4);
#pragma unroll
        for (int i = 0; i < 8; ++i) { const int kk = i * 8 + kr; const float gk = g ? g[k0 + kk] : 1.0f; LAS float* d = scr + kk * 33 + c4;
            d[0] = wv[i][0] * gk; d[1] = wv[i][1] * gk; d[2] = wv[i][2] * gk; d[3] = wv[i][3] * gk; } }
    LDS_WAIT(); asm volatile("" ::: "memory");
    const int c = lane & 7;
#pragma unroll
    for (int j = 0; j < 4; ++j) { const int n = (lane >> 3) + 8 * j; const LAS float* s = scr + (8 * c) * 33 + n;
        v4u o; o.x = pk2(s[0 * 33], s[1 * 33]); o.y = pk2(s[2 * 33], s[3 * 33]); o.z = pk2(s[4 * 33], s[5 * 33]); o.w = pk2(s[6 * 33], s[7 * 33]);
        *(v4u*)(dst + (size_t)(drow0 + n) * ldd + koff + k0 + 8 * c) = o; }
    LDS_WAIT(); asm volatile("" ::: "memory");
}
__device__ __forceinline__ void xb_row2(const float* xa, const float* xb_, bf16* oa, bf16* ob, float* sa, float* sb, int lane) {
    const f32x4* ra = (const f32x4*)xa + lane; const f32x4* rb = (const f32x4*)xb_ + lane;
    f32x4 va[4], vb[4]; float s0 = 0.f, s1 = 0.f;
#pragma unroll
    for (int j = 0; j < 4; ++j) { va[j] = ra[64 * j]; vb[j] = rb[64 * j]; }
#pragma unroll
    for (int j = 0; j < 4; ++j) { s0 += (va[j].x * va[j].x + va[j].y * va[j].y) + (va[j].z * va[j].z + va[j].w * va[j].w); s1 += (vb[j].x * vb[j].x + vb[j].y * vb[j].y) + (vb[j].z * vb[j].z + vb[j].w * vb[j].w); }
#pragma unroll
    for (int o = 1; o < 64; o <<= 1) { s0 += __shfl_xor(s0, o); s1 += __shfl_xor(s1, o); }
    v2u* pa = (v2u*)oa + lane; v2u* pb = (v2u*)ob + lane;
#pragma unroll
    for (int j = 0; j < 4; ++j) { v2u w; w.x = pk2(va[j].x, va[j].y); w.y = pk2(va[j].z, va[j].w); pa[64 * j] = w; v2u z; z.x = pk2(vb[j].x, vb[j].y); z.y = pk2(vb[j].z, vb[j].w); pb[64 * j] = z; }
    if (lane < 16) { sa[lane] = (lane == 0) ? s0 : 0.f; sb[lane] = (lane == 0) ? s1 : 0.f; }
}
__device__ __forceinline__ void xb_row(const float* xrow, bf16* orow, float* ssrow, int lane) {
    const f32x4* xr = (const f32x4*)xrow + lane;
    f32x4 v[4]; float s = 0.f;
#pragma unroll
    for (int j = 0; j < 4; ++j) { v[j] = xr[64 * j]; s += (v[j].x * v[j].x + v[j].y * v[j].y) + (v[j].z * v[j].z + v[j].w * v[j].w); }
    s = wave_sum(s);
    v2u* o8 = (v2u*)orow + lane;
#pragma unroll
    for (int j = 0; j < 4; ++j) { v2u w; w.x = pk2(v[j].x, v[j].y); w.y = pk2(v[j].z, v[j].w); o8[64 * j] = w; }
    if (lane < 16) ssrow[lane] = (lane == 0) ? s : 0.f;
}

constexpr size_t WS_BAR = 256 * 1024;
#define RLX_AGENT __ATOMIC_RELAXED, __HIP_MEMORY_SCOPE_AGENT
#define XB_TMO      128
#define XB_XCNT(j)  (256  + 64 * (j))
#define XB_XSUB(j)  (1280 + 64 * (j))
#define XB_XGEN(j)  (2304 + 64 * (j))
#define XB_TOP      3328
#define XB_TOPGEN   3392
#define XCD_BAR_WORDS 3456
#define XB_SPIN_CAP (1u << 18)

__device__ __forceinline__ unsigned xb_ld(unsigned* p)              { return __hip_atomic_load(p, __ATOMIC_RELAXED, __HIP_MEMORY_SCOPE_AGENT); }
__device__ __forceinline__ unsigned xb_add(unsigned* p, unsigned v) { return __hip_atomic_fetch_add(p, v, __ATOMIC_RELAXED, __HIP_MEMORY_SCOPE_AGENT); }
__device__ __forceinline__ unsigned xb_xcc_id() { return (unsigned)__builtin_amdgcn_s_getreg((3 << 11) | 20) & 0xFu; }
#define XB_SPIN(cond, bar) do { unsigned _sp = 0; while (cond) { __builtin_amdgcn_s_sleep(1); \
    if ((++_sp & 255u) == 0u) { if (xb_ld(&(bar)[XB_TMO])) break; if (_sp > XB_SPIN_CAP) { atomicAdd(&(bar)[XB_TMO], 1u); break; } } } } while (0)

struct XcdBarrier {
    unsigned* bar; unsigned x;
    volatile LAS unsigned* st;
};

__device__ __forceinline__ XcdBarrier xcd_barrier_post(unsigned* bar, volatile LAS unsigned* st) {
    XcdBarrier b; b.bar = bar; b.x = xb_xcc_id(); b.st = st;
    if (threadIdx.x == 0) (void)xb_add(&bar[XB_XCNT(b.x)], 1u);
    return b;
}
__device__ __forceinline__ void xcd_barrier_complete(unsigned* bar, unsigned x, unsigned& nloc, unsigned& nx) {
    const unsigned G = gridDim.x * gridDim.y * gridDim.z;
    unsigned sum, cnt, mine, sp = 0u;
    for (;;) {
        sum = 0u; cnt = 0u; mine = 0u;
#pragma unroll
        for (unsigned j = 0; j < 16; ++j) { const unsigned c = xb_ld(&bar[XB_XCNT(j)]); sum += c; cnt += (c > 0u) ? 1u : 0u; mine = (j == x) ? c : mine; }
        if (sum == G) break;
        __builtin_amdgcn_s_sleep(1);
        if ((++sp & 255u) == 0u) { if (xb_ld(&bar[XB_TMO])) break; if (sp > XB_SPIN_CAP) { atomicAdd(&bar[XB_TMO], 1u); break; } }
    }
    nloc = mine > 0u ? mine : 1u; nx = cnt > 0u ? cnt : 1u;
}

__device__ __forceinline__ void xcd_barrier(const XcdBarrier& b) {
    asm volatile("s_waitcnt vmcnt(0)" ::: "memory");
    __syncthreads();
    if (threadIdx.x == 0) {
        unsigned* bar = b.bar;
        __builtin_amdgcn_s_waitcnt(0);
        unsigned nloc = b.st[0], nx = b.st[1];
        if (nloc == 0u) { xcd_barrier_complete(bar, b.x, nloc, nx); b.st[0] = nloc; b.st[1] = nx; }
        const unsigned old = xb_add(&bar[XB_XSUB(b.x)], 1u);
        const unsigned gen = old / nloc;
        if (old + 1u == (gen + 1u) * nloc) {
            __builtin_amdgcn_fence(__ATOMIC_RELEASE, "agent");
            asm volatile("s_waitcnt vmcnt(0)" ::: "memory");
            const unsigned og = xb_add(&bar[XB_TOP], 1u);
            const unsigned tg = og / nx;
            if (og + 1u == (tg + 1u) * nx) xb_add(&bar[XB_TOPGEN], 1u);
            else XB_SPIN(xb_ld(&bar[XB_TOPGEN]) == tg, bar);
            __builtin_amdgcn_fence(__ATOMIC_ACQUIRE, "agent");
            xb_add(&bar[XB_XGEN(b.x)], 1u);
            asm volatile("s_waitcnt vmcnt(0)" ::: "memory");
        } else {
            XB_SPIN(xb_ld(&bar[XB_XGEN(b.x)]) == gen, bar);
            __builtin_amdgcn_fence(__ATOMIC_ACQUIRE, "agent");
            asm volatile("s_waitcnt vmcnt(0)" ::: "memory");
        }
    }
    __syncthreads();
}

#define GSYNC() xcd_barrier(xbar)
struct Args { const float* in[23]; float* out; unsigned char* ws; };

__global__ void __launch_bounds__(NWAVES * 64, 2) mega_fwd(Args a) {
    extern __shared__ __attribute__((aligned(16))) unsigned char lds_raw[];
    cg::grid_group grid = cg::this_grid();
    LAS unsigned char* lds = (LAS unsigned char*)lds_raw;
    const int tid = threadIdx.x, lane = tid & 63, wave = __builtin_amdgcn_readfirstlane(tid >> 6);
    const int G = gridDim.x, bx = blockIdx.x;
    const int vcu = (G % 8 == 0) ? (bx % 8) * (G / 8) + bx / 8 : bx;
    const int gw = vcu * NWAVES + wave, NGW = G * NWAVES;
    unsigned char* ws = a.ws;
    volatile LAS unsigned* xb_st = (volatile LAS unsigned*)(lds + LDS_BYTES - 64);
    if (tid < 2) xb_st[tid] = 0u;
    __syncthreads();
    const XcdBarrier xbar = xcd_barrier_post((unsigned*)(ws + WS_BAR), xb_st);
    float* xbuf = a.out;
    bf16* Hb = (bf16*)(ws + WS_H); bf16* Tb = (bf16*)(ws + WS_T); bf16* QAb = (bf16*)(ws + WS_QA); bf16* QBb = (bf16*)(ws + WS_QB);
    bf16* ABb = (bf16*)(ws + WS_AB); bf16* Gb = (bf16*)(ws + WS_G); bf16* MGb = (bf16*)(ws + WS_MG); float* rope = (float*)(ws + WS_ROPE); float* SSb = (float*)(ws + WS_SS); float* gnh = (float*)(ws + WS_GNH); float* rpbw = (float*)(ws + WS_RPB); float* subw = (float*)(ws + WS_SUB); float* lamw = (float*)(ws + WS_LAM);

    {
        LAS float* scr = (LAS float*)(lds + wave * 16384);
        constexpr int I0 = 16 * 176, I1 = 44 * 32, I2 = 16 * 160, I3 = 8 * 32, I4 = 8 * 32, I5 = 16 * 32, I6 = I0, I7 = I1;
        constexpr int NI = I0 + I1 + I2 + I3 + I4 + I5 + I6 + I7;
        for (int it = gw; it < NLAYER * NI; it += NGW) {
            const int l = it / NI; int r = it % NI;
            bf16* wl = (bf16*)(ws + WS_W + (size_t)l * WS_WL);
            if (r < I0 || (r >= I0 + I1 + I2 + I3 + I4 + I5 && r < NI - I7)) {
                const bool second = r >= I0; if (second) r -= I0 + I1 + I2 + I3 + I4 + I5;
                const float* W = a.in[second ? 21 : 3] + (size_t)l * 1024 * 5632;
                const int kb = r / 176, nb = r % 176, n0 = nb * 32; const int bj = n0 >= 2816, j = n0 - bj * 2816;
                tr_item(W, 5632, kb * 64, n0, wl + (second ? WO_WI2 : WO_WI1), 256 * (j >> 7) + 128 * bj + (j & 127), 1024, 0, scr, lane, a.in[second ? 20 : 2] + (size_t)l * DM);
                continue;
            }
            if (r >= NI - I7) { r -= NI - I7; const float* W = a.in[22] + (size_t)l * 2816 * 1024; const int kb = r / 32, nb = r % 32;
                tr_item(W, 1024, kb * 64, nb * 32, wl + WO_WO2, nb * 32, 2816, 0, scr, lane); continue; }
            r -= I0;
            if (r < I1) { const float* W = a.in[4] + (size_t)l * 2816 * 1024; const int kb = r / 32, nb = r % 32;
                tr_item(W, 1024, kb * 64, nb * 32, wl + WO_WO1, nb * 32, 2816, 0, scr, lane); continue; }
            r -= I1;
            if (r < I2) { const float* W = a.in[6] + (size_t)l * 1024 * 5120; const int kb = r / 160, nb = r % 160, n0 = nb * 32;
                if (n0 < 3072) { const int blk = n0 >> 8, o = n0 & 255, hh = o >> 6, bb = (o & 63) >> 5;
                    tr_item(W, 5120, kb * 64, n0, wl + WO_QKV, blk * 256 + 128 * bb + 32 * hh, 1024, 0, scr, lane, a.in[5] + (size_t)l * DM); }
                else { const int np = n0 - 3072, pb = np >= 1024, j = np - pb * 1024;
                    tr_item(W, 5120, kb * 64, n0, wl + WO_G, 256 * (j >> 7) + 128 * pb + (j & 127), 1024, 0, scr, lane, a.in[5] + (size_t)l * DM); }
                continue; }
            r -= I2;
            if (r < I3) { const float* W = a.in[17] + (size_t)l * 512 * 1024; const int kb = r / 32, nb = r % 32;
                tr_item(W, 1024, kb * 64, nb * 32, wl + WO_AB, nb * 32, 512, 0, scr, lane); continue; }
            r -= I3;
            if (r < I4) { const float* W = a.in[18] + (size_t)l * 512 * 1024; const int kb = r / 32, nb = r % 32;
                tr_item(W, 1024, kb * 64, nb * 32, wl + WO_AB, 1024 + nb * 32, 512, 0, scr, lane); continue; }
            r -= I4;
            { const float* W = a.in[19] + (size_t)l * 1024 * 1024; const int kb = r / 32, nb = r % 32;
                tr_item(W, 1024, kb * 64, nb * 32, wl + WO_OUT, nb * 32, 1024, 0, scr, lane); }
        }
        for (int mrow = gw; mrow < MTOK; mrow += 2 * NGW) {
            const int m2 = mrow + NGW;
            const float* xa = mrow < NP ? a.in[0] + (size_t)mrow * DM : a.in[1] + (size_t)(mrow - NP) * DM;
            if (m2 < MTOK) { const float* xb2 = m2 < NP ? a.in[0] + (size_t)m2 * DM : a.in[1] + (size_t)(m2 - NP) * DM;
                xb_row2(xa, xb2, Hb + (size_t)mrow * DM, Hb + (size_t)m2 * DM, SSb + (size_t)mrow * 16, SSb + (size_t)m2 * 16, lane); }
            else xb_row(xa, Hb + (size_t)mrow * DM, SSb + (size_t)mrow * 16, lane);
        }
        for (int idx = (vcu * NWAVES * 64 + tid); idx < NLAYER * 6 * 64; idx += G * NWAVES * 64) {
            const int l = idx / 384, p = (idx / 64) % 6, c = idx % 64;
            gnh[idx] = (p == 0) ? a.in[7][l * 64 + c] : (p == 1) ? a.in[8][l * 64 + c] : (p == 3) ? a.in[10][l * 64 + c] : (p == 4) ? a.in[11][l * 64 + c] : 1.0f;
        }
        for (int idx = (vcu * NWAVES * 64 + tid); idx < NLAYER * 3720; idx += G * NWAVES * 64) rpbw[idx] = a.in[9][idx];
        for (int idx = (vcu * NWAVES * 64 + tid); idx < NLAYER * 128; idx += G * NWAVES * 64) subw[idx] = a.in[16][idx];
        if (vcu == 0 && wave < NLAYER) { const int l = wave;
            const float s1 = wave_sum(a.in[12][l * 64 + lane] * a.in[13][l * 64 + lane]), s2 = wave_sum(a.in[14][l * 64 + lane] * a.in[15][l * 64 + lane]);
            if (lane == 0) lamw[l] = expf(s1) - expf(s2) + (0.8f - 0.6f * expf(-0.3f * (float)l)); }
        for (int idx = (vcu * NWAVES * 64 + tid); idx < NP * 8; idx += G * NWAVES * 64) {
            const int pos = idx >> 3, i = idx & 7;
            const float invf = (i == 0) ? 1.0f : (i == 1) ? 0.19392274474868576f : (i == 2) ? 0.03760603093086393f : (i == 3) ? 0.007292664737217109f :
                               (i == 4) ? 0.001414213562373095f : (i == 5) ? 0.0002742481756762073f : (i == 6) ? 5.318295896944988e-05f : 1.031338537721246e-05f;
            const float angf = (float)pos * invf;
            const double ang = (double)angf; const double k = __builtin_rint(ang * 0.15915494309189535); const double r = __builtin_fma(-k, 6.283185307179586, ang) - k * 2.4492935982947064e-16;
            const double x2 = r * r; double ts = 1.0, tc = 1.0, ss = 1.0, sc = 1.0;
#pragma unroll
            for (int q = 1; q <= 14; ++q) { tc = -tc * x2 * (1.0 / (double)((2 * q - 1) * (2 * q))); ts = -ts * x2 * (1.0 / (double)((2 * q) * (2 * q + 1))); sc += tc; ss += ts; }
            rope[pos * 16 + i] = (float)sc; rope[pos * 16 + 8 + i] = (float)(ss * r);
        }
    }
    GSYNC();
    grid.sync();

    float lam = 0.f, one_m_li = 1.f;
    for (int ph = 0; ph < NLAYER * 9; ++ph) {
        const int l = ph / 9, k = ph % 9;
        const bf16* wl = (const bf16*)(ws + WS_W + (size_t)l * WS_WL);
        const bool first_x = (ph == 1);
        if (k == 0 || k == 7) {
            pg8::Gemm g{Hb, wl + (k == 0 ? WO_WI1 : WO_WI2), MTOK, 5632, 1024}; pg8::StaticOrder S; S.init(MTOK, 5632, G, bx, ph & 1);
            pg8::EpiSwiglu E{Tb, SSb};
            pg8::gemm_phase<pg8::EpiSwiglu, pg8::StaticOrder, true, true>(lds, g, S, E);
        } else if (k == 1 || k == 6 || k == 8) {
            pg8::Gemm g{k == 6 ? MGb : Tb, wl + (k == 1 ? WO_WO1 : k == 6 ? WO_OUT : WO_WO2), MTOK, 1024, k == 6 ? 1024 : 2816}; pg8::StaticOrder S; S.init(MTOK, 1024, G, bx, ph & 1);
            pg8::EpiResid E{xbuf, k == 6 ? 1.0f : 0.5f, Hb, SSb, (ph == NLAYER * 9 - 1) ? 1 : 0};
            pg8::gemm_phase<pg8::EpiResid, pg8::StaticOrder, true, true>(lds, g, S, E);
        } else if (k == 2) {
            pg8::Gemm g{Hb, wl + WO_QKV, MTOK, 3072, 1024}; pg8::StaticOrder S; S.init(MTOK, 3072, G, bx, ph & 1);
            pg8::EpiQKV E{QAb, QBb, gnh + l * 384, rope, SSb};
            pg8::gemm_phase<pg8::EpiQKV, pg8::StaticOrder, true, true>(lds, g, S, E);
        } else if (k == 3) {
            const float li = 0.8f - 0.6f * expf(-0.3f * (float)l);
            lam = lamw[l]; one_m_li = 1.0f - li;
            const float* subln = subw + l * 128;
            for (int u = vcu; u < 256 + 1024; u += G) {
                if (u < 256) att::diff_unit(0, NP, u >> 6, u & 63, QBb, ABb, lam, one_m_li, subln, (LAS char*)lds);
                else { const int v = u - 256; att::diff_unit(NP + (v >> 6) * 4096, 4096, (v >> 4) & 3, v & 15, QBb, ABb, lam, one_m_li, subln, (LAS char*)lds); }
            }
            const float* rpb = rpbw + (size_t)l * 8 * 15 * 31;
            __syncthreads();
            att::na_wave_units(gw, NGW, QAb, ABb, rpb, (LAS char*)lds);
        } else if (k == 4) {
            pg8::Gemm g{ABb, wl + WO_AB, MTOK, 2048, 512, 1024, 1024}; pg8::StaticOrder S; S.init(MTOK, 2048, G, bx, ph & 1);
            pg8::EpiY E{Gb};
            pg8::gemm_phase<pg8::EpiY, pg8::StaticOrder, false, true>(lds, g, S, E);
        } else {
            pg8::Gemm g{Hb, wl + WO_G, MTOK, 2048, 1024}; pg8::StaticOrder S; S.init(MTOK, 2048, G, bx, ph & 1);
            pg8::EpiGateMerge E{Gb, MGb, SSb};
            pg8::gemm_phase<pg8::EpiGateMerge, pg8::StaticOrder, true, true>(lds, g, S, E);
        }
        if (ph != NLAYER * 9 - 1) GSYNC();
    }
}

extern "C" void kernel_launch(void* const* d_in, const int* in_sizes, int n_in, void* d_out, int out_size, void* d_ws, size_t ws_size, hipStream_t stream) {
    static int grid = 0;
    if (grid == 0) {
        if (n_in != 23 || out_size != MTOK * DM || ws_size < WS_END) { fprintf(stderr, "kernel_launch: unexpected shapes: n_in %d out %d ws %zu (need >= %zu)\n", n_in, out_size, ws_size, (size_t)WS_END); grid = -1; return; }
        int dev = 0, cus = 0, per_cu = 0;
        (void)hipGetDevice(&dev); (void)hipDeviceGetAttribute(&cus, hipDeviceAttributeMultiprocessorCount, dev);
        if (hipFuncSetAttribute((const void*)mega_fwd, hipFuncAttributeMaxDynamicSharedMemorySize, LDS_BYTES) != hipSuccess) { fprintf(stderr, "kernel_launch: hipFuncSetAttribute failed\n"); grid = -1; return; }
        if (hipOccupancyMaxActiveBlocksPerMultiprocessor(&per_cu, (const void*)mega_fwd, NWAVES * 64, LDS_BYTES) != hipSuccess || per_cu < 1) { fprintf(stderr, "kernel_launch: occupancy query says %d\n", per_cu); per_cu = 1; }
        (void)hipGetLastError();
        grid = cus * per_cu;
        fprintf(stderr, "kernel_launch: grid %d (cus %d x %d)\n", grid, cus, per_cu);
    }
    if (grid < 0) return;
    if (hipMemsetAsync((char*)d_ws + WS_BAR, 0, 16384, stream) != hipSuccess) { fprintf(stderr, "kernel_launch: memset failed\n"); return; }
    Args a{};
    for (int i = 0; i < 23; ++i) a.in[i] = (const float*)d_in[i];
    a.out = (float*)d_out; a.ws = (unsigned char*)d_ws;
    void* args[] = {&a};
    const hipError_t e = hipLaunchCooperativeKernel((const void*)mega_fwd, dim3(grid), dim3(NWAVES * 64), args, LDS_BYTES, stream);
    if (e != hipSuccess) fprintf(stderr, "kernel_launch: cooperative launch failed: %s (grid %d)\n", hipGetErrorString(e), grid);
}
```

```cpp
#include <hip/hip_runtime.h>
#include <hip/hip_cooperative_groups.h>
#include <cstdio>
#include <cstdint>
namespace cg = cooperative_groups;
namespace pg8 {
#define PG8_LAS __attribute__((address_space(3)))
typedef unsigned short bf16_t;
typedef short bf16x8 __attribute__((ext_vector_type(8)));
typedef float f32x4 __attribute__((ext_vector_type(4)));
typedef unsigned u32x4 __attribute__((ext_vector_type(4)));
constexpr int BM = 256, BK = 64, HALF = 128, HTB = HALF * BK * 2  , STAGE_BYTES = 8 * HTB, NXCD = 8, WGM = 8;

__host__ __device__ __forceinline__ int lds_byte(int r, int c) { const int st = (r >> 4) * 2 + (c >> 5), rr = r & 15, cc = c & 31, ob = rr * 64 + cc * 2; return st * 1024 + (ob ^ (((ob >> 9) & 1) << 5)); }
__host__ __device__ __forceinline__ void stage_rc(int b, int& R, int& C) { const int st = b / 1024, sb = b % 1024, swz = sb ^ (((sb >> 9) & 1) << 5); R = (st >> 1) * 16 + swz / 64; C = (st & 1) * 32 + (swz % 64) / 2; }
__host__ __device__ __forceinline__ int perm32(int rho) { const int n = rho >> 4, i = rho & 15; return 8 * (i >> 2) + 4 * n + (i & 3); }

struct Unit { int pm, pn; };
struct Gemm { const bf16_t* A; const bf16_t* Bt; int M, N, K; int lda = 0, aselb = 0; };

struct StaticOrder {
    int nM, nN, nwg, G, c, nr, rev;
    __host__ __device__ void init(int M, int N, int G_, int c_, int rev_ = 0) { nM = M / BM; nN = N / BM; nwg = nM * nN; G = G_; c = c_; rev = rev_; nr = (c < nwg) ? (nwg - c + G - 1) / G : 0; }
    __host__ __device__ bool next(int i, Unit& u) const {
        if (i >= nr) return false;
        const long L = (long)(rev ? nr - 1 - i : i) * G + c;
        int wgid = (int)L; { const int q = nwg / NXCD, r = nwg % NXCD, xcd = wgid % NXCD, off = wgid / NXCD; wgid = (xcd < r ? xcd * (q + 1) : r * (q + 1) + (xcd - r) * q) + off; }
        const int nig = WGM * nN, gid = wgid / nig, fm = gid * WGM, gsz = (nM - fm) < WGM ? (nM - fm) : WGM;
        u.pm = fm + ((wgid % nig) % gsz); u.pn = (wgid % nig) / gsz; return true;
    }
    __device__ __forceinline__ void a_ready(const Unit&) const {}
    __device__ __forceinline__ void done(const Unit&) const {}
};

typedef float f32x2c_ __attribute__((ext_vector_type(2))); typedef __bf16 bf16x2c_ __attribute__((ext_vector_type(2)));
__device__ __forceinline__ unsigned cvt_pk_bf16(float lo, float hi) { f32x2c_ v = {lo, hi}; bf16x2c_ b = __builtin_convertvector(v, bf16x2c_); return __builtin_bit_cast(unsigned, b); }
typedef float f32x2 __attribute__((ext_vector_type(2)));
typedef unsigned u32x2 __attribute__((ext_vector_type(2)));
constexpr int DM_ = 1024, DFF_ = 2816, LDQKV_ = 1536, LDG_ = 2048;
constexpr float LOG2E_ = 1.4426950408889634f;
constexpr float QSCALE_ = 0.125f * 1.4426950408889634f;
__device__ __forceinline__ float sigm(float x) { return __builtin_amdgcn_rcpf(1.f + __builtin_amdgcn_exp2f(-LOG2E_ * x)); }
__device__ __forceinline__ float bf_lo(unsigned w) { return __uint_as_float(w << 16); }
__device__ __forceinline__ float bf_hi(unsigned w) { return __uint_as_float(w & 0xffff0000u); }
__device__ __forceinline__ u32x4 pack8(const f32x4 a, const f32x4 b) { u32x4 w; w.x = cvt_pk_bf16(a[0], a[1]); w.y = cvt_pk_bf16(a[2], a[3]); w.z = cvt_pk_bf16(b[0], b[1]); w.w = cvt_pk_bf16(b[2], b[3]); return w; }


__device__ __forceinline__ void row_rstd(const float* SS, int row0, int fq, float (&rs)[2][4]) {
    f32x4 pv[2][4];
#pragma unroll
    for (int ai = 0; ai < 2; ++ai)
#pragma unroll
        for (int m = 0; m < 4; ++m) pv[ai][m] = *(const f32x4*)(SS + (size_t)(row0 + ai * HALF + m * 16) * 16 + 4 * fq);
#pragma unroll
    for (int ai = 0; ai < 2; ++ai)
#pragma unroll
        for (int m = 0; m < 4; ++m) { float s = (pv[ai][m][0] + pv[ai][m][1]) + (pv[ai][m][2] + pv[ai][m][3]); s += __shfl_xor(s, 16); s += __shfl_xor(s, 32);
            rs[ai][m] = __builtin_amdgcn_rsqf(s * (1.0f / 1024.0f) + 1e-6f); }
}

struct EpiSwiglu {
    static constexpr bool PERM = true, AFTER_DRAIN = false, MID = false;
    bf16_t* T; const float* SS;
    __device__ __forceinline__ void operator()(const f32x4 (&acc)[2][2][4][2], const Unit& u, int wr, int wc, int fr, int fq) const {
        const int row0 = u.pm * BM + wr * 64 + fr, col0 = u.pn * 128 + wc * 32 + 8 * fq;
        float rs[2][4]; row_rstd(SS, row0, fq, rs);
#pragma unroll
        for (int ai = 0; ai < 2; ++ai)
#pragma unroll
            for (int m = 0; m < 4; ++m) {
                bf16_t* rowp = T + (size_t)(row0 + ai * HALF + m * 16) * DFF_ + col0;
                f32x4 v[2];
#pragma unroll
                for (int n = 0; n < 2; ++n)
#pragma unroll
                    for (int i = 0; i < 4; ++i) { const float a = acc[ai][0][m][n][i] * rs[ai][m], b = acc[ai][1][m][n][i] * rs[ai][m]; v[n][i] = a * sigm(a) * b; }
                *(u32x4*)rowp = pack8(v[0], v[1]);
            }
    }
};
struct EpiResid {
    static constexpr bool PERM = true, AFTER_DRAIN = false, MID = false;
    float* xout; float s; bf16_t* XB; float* SS; int final_;
    __device__ __forceinline__ void operator()(const f32x4 (&acc)[2][2][4][2], const Unit& u, int wr, int wc, int fr, int fq) const {
        const int col0 = u.pn * BM + wc * 32 + 8 * fq;
        u32x4 xall[2][4][2];
#pragma unroll
        for (int ai = 0; ai < 2; ++ai)
#pragma unroll
            for (int m = 0; m < 4; ++m)
#pragma unroll
                for (int bj = 0; bj < 2; ++bj) xall[ai][m][bj] = *(const u32x4*)(XB + (size_t)(u.pm * BM + ai * HALF + wr * 64 + m * 16 + fr) * DM_ + col0 + bj * HALF);
#pragma unroll
        for (int ai = 0; ai < 2; ++ai)
#pragma unroll
            for (int m = 0; m < 4; ++m) {
                const int row = u.pm * BM + ai * HALF + wr * 64 + m * 16 + fr;
                const size_t off = (size_t)row * DM_ + col0;
                u32x4 xb[2];
#pragma unroll
                for (int bj = 0; bj < 2; ++bj) xb[bj] = xall[ai][m][bj];
                float ss = 0.f;
#pragma unroll
                for (int bj = 0; bj < 2; ++bj) {
                    f32x4 xv[2];
#pragma unroll
                    for (int w = 0; w < 4; ++w) { xv[w >> 1][(w & 1) * 2] = bf_lo(xb[bj][w]) + acc[ai][bj][m][w >> 1][(w & 1) * 2] * s; xv[w >> 1][(w & 1) * 2 + 1] = bf_hi(xb[bj][w]) + acc[ai][bj][m][w >> 1][(w & 1) * 2 + 1] * s; }
                    if (final_) { *(f32x4*)(xout + off + bj * HALF) = xv[0]; *(f32x4*)(xout + off + bj * HALF + 4) = xv[1]; }
                    else {
#pragma unroll
                        for (int n = 0; n < 2; ++n) ss += (xv[n][0] * xv[n][0] + xv[n][1] * xv[n][1]) + (xv[n][2] * xv[n][2] + xv[n][3] * xv[n][3]);
                        *(u32x4*)(XB + off + bj * HALF) = pack8(xv[0], xv[1]);
                    }
                }
                if (!final_) { ss += __shfl_xor(ss, 16); ss += __shfl_xor(ss, 32); if (fq == 0) SS[(size_t)row * 16 + u.pn * 4 + wc] = ss; }
                asm volatile("" ::: "memory");
            }
    }
};
struct EpiQKV {
    static constexpr bool PERM = true, AFTER_DRAIN = false, MID = false;
    bf16_t* QA; bf16_t* QB; const float* gn; const float* rope; const float* SS;
    __device__ __forceinline__ void operator()(const f32x4 (&acc)[2][2][4][2], const Unit& u, int wr, int wc, int fr, int fq) const {
        const int part = u.pn >> 1, sub = u.pn & 1, p3 = part % 3;
        bf16_t* dst = (part < 3) ? QA : QB;
        const int pcol = p3 * 512 + sub * 256 + wc * 64 + 8 * fq;
        const bool isqk = (p3 != 2), isq = (p3 == 0), dorope = (part >= 3) && isqk;
        const float* g = gn + part * 64;
        f32x4 gv[2][2];
#pragma unroll
        for (int bj = 0; bj < 2; ++bj)
#pragma unroll
            for (int n = 0; n < 2; ++n) gv[bj][n] = *(const f32x4*)(g + 32 * bj + 8 * fq + 4 * n);
        float rsx[2][4]; row_rstd(SS, u.pm * BM + wr * 64 + fr, fq, rsx);
#pragma unroll
        for (int ai = 0; ai < 2; ++ai)
#pragma unroll
            for (int m = 0; m < 4; ++m) {
                const int row = u.pm * BM + ai * HALF + wr * 64 + m * 16 + fr;
                f32x4 v[2][2];
#pragma unroll
                for (int bj = 0; bj < 2; ++bj)
#pragma unroll
                    for (int n = 0; n < 2; ++n) v[bj][n] = acc[ai][bj][m][n] * rsx[ai][m];
                if (isqk) {
                    float ss = 0.f;
#pragma unroll
                    for (int bj = 0; bj < 2; ++bj)
#pragma unroll
                        for (int n = 0; n < 2; ++n) ss += (v[bj][n][0] * v[bj][n][0] + v[bj][n][1] * v[bj][n][1]) + (v[bj][n][2] * v[bj][n][2] + v[bj][n][3] * v[bj][n][3]);
                    ss += __shfl_xor(ss, 16); ss += __shfl_xor(ss, 32);
                    const float rs = __builtin_amdgcn_rsqf(ss * (1.0f / 64.0f) + 1e-6f);
#pragma unroll
                    for (int bj = 0; bj < 2; ++bj)
#pragma unroll
                        for (int n = 0; n < 2; ++n) v[bj][n] = v[bj][n] * rs * gv[bj][n];
                    if (dorope) {
                        const int pos = (row < 16384) ? row : ((row - 16384) & 4095);
                        const float* cs = rope + (size_t)pos * 16;
#pragma unroll
                        for (int n = 0; n < 2; ++n) {
                            const f32x4 c = *(const f32x4*)(cs + 4 * n), s = *(const f32x4*)(cs + 8 + 4 * n);
                            const f32x4 me = v[0][n]; f32x4 ot;
#pragma unroll
                            for (int i = 0; i < 4; ++i) ot[i] = __shfl_xor(me[i], 16);
                            const f32x4 r0 = me * c - ot * s, r1 = me * c + ot * s;
                            if (fq == 0) v[0][n] = r0; else if (fq == 1) v[0][n] = r1;
                        }
                    }
                    if (isq) {
#pragma unroll
                        for (int bj = 0; bj < 2; ++bj)
#pragma unroll
                            for (int n = 0; n < 2; ++n) v[bj][n] = v[bj][n] * QSCALE_;
                    }
                }
                bf16_t* rowp = dst + (size_t)row * LDQKV_ + pcol;
#pragma unroll
                for (int bj = 0; bj < 2; ++bj) *(u32x4*)(rowp + 32 * bj) = pack8(v[bj][0], v[bj][1]);
            }
    }
};
struct EpiY {
    static constexpr bool PERM = true, AFTER_DRAIN = false, MID = false;
    bf16_t* Y;
    __device__ __forceinline__ void operator()(const f32x4 (&acc)[2][2][4][2], const Unit& u, int wr, int wc, int fr, int fq) const {
        const int row0 = u.pm * BM + wr * 64 + fr, col0 = u.pn * BM + wc * 32 + 8 * fq;
#pragma unroll
        for (int ai = 0; ai < 2; ++ai)
#pragma unroll
            for (int m = 0; m < 4; ++m) {
                bf16_t* rowp = Y + (size_t)(row0 + ai * HALF + m * 16) * LDG_ + col0;
#pragma unroll
                for (int bj = 0; bj < 2; ++bj) *(u32x4*)(rowp + bj * HALF) = pack8(acc[ai][bj][m][0], acc[ai][bj][m][1]);
            }
    }
};
struct EpiGateMerge {
    static constexpr bool PERM = true, AFTER_DRAIN = false, MID = false;
    const bf16_t* Y; bf16_t* MG; const float* SS;
    __device__ __forceinline__ void operator()(const f32x4 (&acc)[2][2][4][2], const Unit& u, int wr, int wc, int fr, int fq) const {
        const int row0 = u.pm * BM + wr * 64 + fr, col0 = u.pn * 128 + wc * 32 + 8 * fq;
        u32x4 ya[4], yb[4];
#pragma unroll
        for (int m = 0; m < 4; ++m) { const bf16_t* yp = Y + (size_t)(row0 + m * 16) * LDG_ + col0; ya[m] = *(const u32x4*)yp; yb[m] = *(const u32x4*)(yp + 1024); }
        float rs[2][4]; row_rstd(SS, row0, fq, rs);
#pragma unroll
        for (int ai = 0; ai < 2; ++ai) {
            if (ai == 1) {
#pragma unroll
                for (int m = 0; m < 4; ++m) { const bf16_t* yp = Y + (size_t)(row0 + HALF + m * 16) * LDG_ + col0; ya[m] = *(const u32x4*)yp; yb[m] = *(const u32x4*)(yp + 1024); }
            }
#pragma unroll
            for (int m = 0; m < 4; ++m) {
                f32x4 v[2];
#pragma unroll
                for (int w = 0; w < 4; ++w) {
                    const int n = w >> 1, i0 = (w & 1) * 2;
                    v[n][i0]     = sigm(acc[ai][0][m][n][i0]     * rs[ai][m]) * bf_lo(ya[m][w]) + sigm(acc[ai][1][m][n][i0]     * rs[ai][m]) * bf_lo(yb[m][w]);
                    v[n][i0 + 1] = sigm(acc[ai][0][m][n][i0 + 1] * rs[ai][m]) * bf_hi(ya[m][w]) + sigm(acc[ai][1][m][n][i0 + 1] * rs[ai][m]) * bf_hi(yb[m][w]);
                }
                *(u32x4*)(MG + (size_t)(row0 + ai * HALF + m * 16) * DM_ + col0) = pack8(v[0], v[1]);
            }
            asm volatile("" ::: "memory");
        }
    }
};
template <class Epi, class Sched, bool ALIGN_EPI = false, bool SP2 = false>
__device__ __forceinline__ void gemm_phase(PG8_LAS unsigned char* lds, const Gemm g, const Sched& S, const Epi& E) {
    int tid_ = threadIdx.x; asm volatile("" : "+v"(tid_));
    const int tid = tid_, wid = __builtin_amdgcn_readfirstlane(tid >> 6), lane = tid & 63, wr = wid >> 2, wc = wid & 3, fr = lane & 15, fq = lane >> 4;
    const int K = g.K, nt = K / BK, lda = g.lda ? g.lda : g.K;
    unsigned voffA[2], voffB[2];
#pragma unroll
    for (int i = 0; i < 2; ++i) { int R, C; stage_rc(tid * 16 + i * 8192, R, C); const int Rb = Epi::PERM ? ((R & ~31) + perm32(R & 31)) : R;
        voffA[i] = (unsigned)(R * lda + C) * 2u; voffB[i] = (unsigned)(Rb * K + C) * 2u; }
    const size_t kstep = (size_t)(BK * 2);
    const size_t hstep = (size_t)HALF * K * 2;
    const size_t tstep = 2 * hstep;
    const size_t hstepA = (size_t)HALF * lda * 2, tstepA = 2 * hstepA;
    const unsigned ldsw = (unsigned)wid * 1024u;
    const int aoff = lds_byte(wr * 64 + fr, fq * 8), boff = lds_byte(wc * 32 + fr, fq * 8);
#define PG8_SA(b, h) (((b) * 2 + (h)) * HTB)
#define PG8_SB(b, h) ((4 + (b) * 2 + (h)) * HTB)
#define PG8_STAGE(bufoff, gbase, voff) do { _Pragma("unroll") for (int _i = 0; _i < 2; ++_i) \
        __builtin_amdgcn_global_load_lds((const unsigned*)((const char*)(gbase) + (voff)[_i]), (PG8_LAS unsigned*)(lds + (bufoff) + ldsw + _i * 8192), 16, 0, 0); } while (0)
#define PG8_LDA(dst, b, h) do { _Pragma("unroll") for (int m = 0; m < 4; ++m) _Pragma("unroll") for (int k = 0; k < 2; ++k) dst[m][k] = *(const PG8_LAS bf16x8*)(lds + PG8_SA(b, h) + aoff + m * 2048 + k * 1024); } while (0)
#define PG8_LDB(dst, b, h) do { _Pragma("unroll") for (int n = 0; n < 2; ++n) _Pragma("unroll") for (int k = 0; k < 2; ++k) dst[n][k] = *(const PG8_LAS bf16x8*)(lds + PG8_SB(b, h) + boff + n * 2048 + k * 1024); } while (0)
#define PG8_MMA(ai, bj, At, Bt) do { __builtin_amdgcn_s_setprio(1); _Pragma("unroll") for (int m = 0; m < 4; ++m) _Pragma("unroll") for (int n = 0; n < 2; ++n) _Pragma("unroll") for (int k = 0; k < 2; ++k) \
        acc[ai][bj][m][n] = __builtin_amdgcn_mfma_f32_16x16x32_bf16(Bt[n][k], At[m][k], acc[ai][bj][m][n], 0, 0, 0); __builtin_amdgcn_s_setprio(0); } while (0)
#define PG8_WAIT_V(n) asm volatile("s_waitcnt vmcnt(" #n ")" ::: "memory")
#define PG8_WAIT_L(n) asm volatile("s_waitcnt lgkmcnt(" #n ")" ::: "memory")
#define PG8_BAR __builtin_amdgcn_s_barrier()
#define PG8_SCHED __builtin_amdgcn_sched_barrier(0)
    Unit cur, nxt; int ui = 0;
    if (!S.next(0, cur)) return;
    f32x4 acc[2][2][4][2];
#pragma unroll
    for (int a = 0; a < 2; ++a)
#pragma unroll
        for (int b = 0; b < 2; ++b)
#pragma unroll
            for (int m = 0; m < 4; ++m)
#pragma unroll
                for (int n = 0; n < 2; ++n) acc[a][b][m][n] = (f32x4){0.f, 0.f, 0.f, 0.f};
    bf16x8 At[4][2], B0[2][2], B1[2][2];
    const char* cA = (const char*)g.A + (size_t)cur.pm * tstepA + (size_t)(cur.pn >> 2) * g.aselb; const char* cB = (const char*)g.Bt + (size_t)cur.pn * tstep;
    S.a_ready(cur);
    if constexpr (SP2) {
        PG8_STAGE(PG8_SB(0, 0), cB, voffB); PG8_STAGE(PG8_SB(0, 1), cB + hstep, voffB); PG8_STAGE(PG8_SA(0, 0), cA, voffA); PG8_STAGE(PG8_SA(0, 1), cA + hstepA, voffA);
        if (wr == 1) PG8_BAR;
        PG8_WAIT_V(2); PG8_BAR;
        PG8_STAGE(PG8_SB(1, 0), cB + kstep, voffB); PG8_STAGE(PG8_SA(1, 0), cA + kstep, voffA); PG8_STAGE(PG8_SB(1, 1), cB + hstep + kstep, voffB);
        PG8_WAIT_V(6); PG8_BAR;
    } else {
        PG8_STAGE(PG8_SB(0, 0), cB, voffB); PG8_STAGE(PG8_SA(0, 0), cA, voffA); PG8_STAGE(PG8_SB(0, 1), cB + hstep, voffB); PG8_STAGE(PG8_SA(0, 1), cA + hstepA, voffA);
        if (wr == 1) PG8_BAR;
        PG8_WAIT_V(4); PG8_BAR;
        PG8_STAGE(PG8_SB(1, 0), cB + kstep, voffB); PG8_STAGE(PG8_SA(1, 0), cA + kstep, voffA); PG8_STAGE(PG8_SB(1, 1), cB + hstep + kstep, voffB);
        PG8_WAIT_V(6); PG8_BAR;
    }
    for (;;) {
        const bool has_next = S.next(ui + 1, nxt);
        const char* nA = has_next ? (const char*)g.A + (size_t)nxt.pm * tstepA + (size_t)(nxt.pn >> 2) * g.aselb : cA; const char* nB = has_next ? (const char*)g.Bt + (size_t)nxt.pn * tstep : cB;
        for (int t = 0; t < nt; t += 2) {
            if constexpr (Epi::MID) { if (t == (nt >> 1)) E.mid(acc, cur, wr, wc, fr, fq); }
            const bool last = (t == nt - 2);
            const char* a1 = cA + (size_t)(t + 1) * kstep;
            const char* a2 = last ? nA : cA + (size_t)(t + 2) * kstep; const char* b2 = last ? nB : cB + (size_t)(t + 2) * kstep;
            const char* a3 = a2 + kstep; const char* b3 = b2 + kstep;
            if (last && has_next) S.a_ready(nxt);
            if constexpr (SP2) {
            PG8_LDB(B0, 0, 0); PG8_LDB(B1, 0, 1); PG8_SCHED; PG8_LDA(At, 0, 0); PG8_STAGE(PG8_SA(1, 1), a1 + hstepA, voffA);
            PG8_WAIT_V(8); PG8_WAIT_L(0); PG8_BAR; PG8_MMA(0, 0, At, B0); PG8_MMA(0, 1, At, B1); PG8_BAR; PG8_SCHED;
            PG8_LDA(At, 0, 1); PG8_STAGE(PG8_SB(0, 0), b2, voffB); PG8_STAGE(PG8_SB(0, 1), b2 + hstep, voffB); PG8_STAGE(PG8_SA(0, 0), a2, voffA);
            PG8_WAIT_V(8); PG8_WAIT_L(0); PG8_BAR; PG8_MMA(1, 0, At, B0); PG8_MMA(1, 1, At, B1); PG8_BAR; PG8_SCHED;
            PG8_LDB(B0, 1, 0); PG8_LDB(B1, 1, 1); PG8_SCHED; PG8_LDA(At, 1, 0); PG8_STAGE(PG8_SA(0, 1), a2 + hstepA, voffA);
            PG8_WAIT_V(8); PG8_WAIT_L(0); PG8_BAR; PG8_MMA(0, 0, At, B0); PG8_MMA(0, 1, At, B1); PG8_BAR; PG8_SCHED;
            PG8_LDA(At, 1, 1); PG8_STAGE(PG8_SB(1, 0), b3, voffB); PG8_STAGE(PG8_SB(1, 1), b3 + hstep, voffB); PG8_STAGE(PG8_SA(1, 0), a3, voffA);
            PG8_WAIT_V(8); PG8_WAIT_L(0); PG8_BAR; PG8_MMA(1, 0, At, B0); PG8_MMA(1, 1, At, B1); PG8_BAR; PG8_SCHED;
            } else {
            PG8_LDB(B0, 0, 0); PG8_SCHED; PG8_LDA(At, 0, 0); PG8_STAGE(PG8_SA(1, 1), a1 + hstepA, voffA);
            PG8_WAIT_L(8); PG8_BAR; PG8_WAIT_L(0); PG8_MMA(0, 0, At, B0); PG8_BAR; PG8_SCHED;
            PG8_LDB(B1, 0, 1); PG8_STAGE(PG8_SB(0, 0), b2, voffB);
            PG8_BAR; PG8_WAIT_L(0); PG8_MMA(0, 1, At, B1); PG8_BAR;
            PG8_LDA(At, 0, 1); PG8_STAGE(PG8_SA(0, 0), a2, voffA);
            PG8_BAR; PG8_WAIT_L(0); PG8_MMA(1, 0, At, B0); PG8_BAR; PG8_SCHED;
            PG8_STAGE(PG8_SB(0, 1), b2 + hstep, voffB);
            PG8_WAIT_V(6); PG8_BAR; PG8_MMA(1, 1, At, B1); PG8_BAR;
            PG8_LDB(B0, 1, 0); PG8_SCHED; PG8_LDA(At, 1, 0); PG8_STAGE(PG8_SA(0, 1), a2 + hstepA, voffA);
            PG8_WAIT_L(8); PG8_BAR; PG8_WAIT_L(0); PG8_MMA(0, 0, At, B0); PG8_BAR; PG8_SCHED;
            PG8_LDB(B1, 1, 1); PG8_STAGE(PG8_SB(1, 0), b3, voffB);
            PG8_BAR; PG8_WAIT_L(0); PG8_MMA(0, 1, At, B1); PG8_BAR;
            PG8_LDA(At, 1, 1); PG8_STAGE(PG8_SA(1, 0), a3, voffA);
            PG8_BAR; PG8_WAIT_L(0); PG8_MMA(1, 0, At, B0); PG8_BAR; PG8_SCHED;
            PG8_STAGE(PG8_SB(1, 1), b3 + hstep, voffB);
            PG8_WAIT_V(6); PG8_BAR; PG8_MMA(1, 1, At, B1); PG8_BAR;
            }
        }
        if constexpr (ALIGN_EPI) { if (wr == 0) PG8_BAR; }
        if constexpr (!Epi::AFTER_DRAIN) { E(acc, cur, wr, wc, fr, fq); S.done(cur); }
        if (!has_next) break;
#pragma unroll
        for (int a = 0; a < 2; ++a)
#pragma unroll
            for (int b = 0; b < 2; ++b)
#pragma unroll
                for (int m = 0; m < 4; ++m)
#pragma unroll
                    for (int n = 0; n < 2; ++n) acc[a][b][m][n] = (f32x4){0.f, 0.f, 0.f, 0.f};
        cur = nxt; cA = nA; cB = nB; ++ui;
        if constexpr (ALIGN_EPI) { if (wr == 1) PG8_BAR; }
    }
    PG8_WAIT_V(0);
    if constexpr (!ALIGN_EPI) { if (wr == 0) PG8_BAR; }
    PG8_BAR;
    if constexpr (Epi::AFTER_DRAIN) { E.fused(acc, cur, wr, wc, fr, fq, lds, wid, lane); S.done(cur); }
#undef PG8_SA
#undef PG8_SB
#undef PG8_STAGE
#undef PG8_LDA
#undef PG8_LDB
#undef PG8_MMA
#undef PG8_WAIT_V
#undef PG8_WAIT_L
#undef PG8_BAR
#undef PG8_SCHED
}
}
namespace att {
#define ALAS __attribute__((address_space(3)))
typedef unsigned short bf16_t;
using bf16x8 = __attribute__((ext_vector_type(8))) short;
using s16x4  = __attribute__((ext_vector_type(4))) short;
using f32x16 = __attribute__((ext_vector_type(16))) float;
using u32x4  = __attribute__((ext_vector_type(4))) unsigned;
constexpr int LD = 1536;
constexpr int SHM_K = 8192, SHM_V = 16384;
constexpr int L_V = 0, L_K = 2 * SHM_V, L_WS = L_K + 2 * SHM_K, L_TAB = L_WS + 2048, L_STASH = L_TAB + 2048, L_END = L_STASH + 65536;
constexpr float THR2 = 8.f;
#define KSWZ(row, colB) ((row) * 128 + ((colB) ^ ((((row) >> 1) & 7) << 4)))
#define SBAR() __builtin_amdgcn_sched_barrier(0)
__device__ __forceinline__ int crow(int r, int hi) { return (r & 3) + 8 * (r >> 2) + 4 * hi; }
typedef float f32x2c_ __attribute__((ext_vector_type(2))); typedef __bf16 bf16x2c_ __attribute__((ext_vector_type(2)));
__device__ __forceinline__ unsigned cvtpk(float lo, float hi) { f32x2c_ v = {lo, hi}; bf16x2c_ b = __builtin_convertvector(v, bf16x2c_); return __builtin_bit_cast(unsigned, b); }

struct NaCtx { int klo, rq, s0q, qc, wstart; const ALAS float* tab; };
__device__ __forceinline__ void na_bias(f32x16& p0, f32x16& p1, int t, int hi, const NaCtx& c) {
  const int kr = c.klo + t; const bool active = (kr >= c.s0q) && (kr <= c.s0q + 7);
  if (!active) {
#pragma unroll
    for (int r = 0; r < 16; ++r) { p0[r] = -1e30f; p1[r] = -1e30f; }
    return;
  }
  const int tb = (kr - c.rq + 7) * 32 + 15 - c.qc;
#pragma unroll
  for (int r = 0; r < 16; ++r) {
    const int kc = crow(r, hi);
    { const bool v = (unsigned)(kc - c.wstart) < 16u; const float b = c.tab[v ? tb + kc : 0]; p0[r] = v ? p0[r] + b : -1e30f; }
    { const int k2 = kc + 32; const bool v = (unsigned)(k2 - c.wstart) < 16u; const float b = c.tab[v ? tb + k2 : 0]; p1[r] = v ? p1[r] + b : -1e30f; }
  }
}
__device__ __forceinline__ void k_issue(bf16x8 (&kf)[8], const ALAS char* Ks, int r32, int hi) {
#pragma unroll
  for (int d0 = 0; d0 < 4; ++d0) { const int cb = (d0 * 16 + hi * 8) * 2;
    kf[2 * d0] = *(const ALAS bf16x8*)(Ks + KSWZ(r32, cb)); kf[2 * d0 + 1] = *(const ALAS bf16x8*)(Ks + KSWZ(32 + r32, cb)); }
}
__device__ __forceinline__ void qkt(f32x16& p0, f32x16& p1, const bf16x8 (&kf)[8], const bf16x8* qr, const f32x16& cinit) {
  p0 = __builtin_amdgcn_mfma_f32_32x32x16_bf16(kf[0], qr[0], cinit, 0, 0, 0); p1 = __builtin_amdgcn_mfma_f32_32x32x16_bf16(kf[1], qr[0], cinit, 0, 0, 0);
#pragma unroll
  for (int d0 = 1; d0 < 4; ++d0) { p0 = __builtin_amdgcn_mfma_f32_32x32x16_bf16(kf[2 * d0], qr[d0], p0, 0, 0, 0); p1 = __builtin_amdgcn_mfma_f32_32x32x16_bf16(kf[2 * d0 + 1], qr[d0], p1, 0, 0, 0); }
}
template <int NC> __device__ __forceinline__ int v_st(int k, int c) { const int kk = (k & ~0xC) | ((k & 4) << 1) | ((k & 8) >> 1); return ((kk >> 3) * NC + (c >> 5)) * 512 + ((kk & 7) * 32 + (c & 31)) * 2; }
__device__ __forceinline__ int v_rd_base(int lane) { return ((lane & 3) << 3) | (((lane >> 2) & 3) << 6) | (((lane >> 4) & 1) << 5) | (((lane >> 5) & 1) << 8); }
template <int NC> constexpr int v_rd_off(int d0, int ks, int half) { return d0 * 512 + (2 * ks + half) * NC * 512; }
template <int OFF> __device__ __forceinline__ s16x4 tr_read(int vb) {
  s16x4 r; asm volatile("ds_read_b64_tr_b16 %0, %1 offset:%2" : "=&v"(r) : "v"(vb), "i"(OFF) : "memory"); return r;
}
template <int NC, int KS> __device__ __forceinline__ void v_issue_k(s16x4 (&L)[8], int vb) {
  L[0] = tr_read<v_rd_off<NC>(0, KS, 0)>(vb); L[1] = tr_read<v_rd_off<NC>(0, KS, 1)>(vb); L[2] = tr_read<v_rd_off<NC>(1, KS, 0)>(vb); L[3] = tr_read<v_rd_off<NC>(1, KS, 1)>(vb);
  if constexpr (NC == 4) { L[4] = tr_read<v_rd_off<NC>(2, KS, 0)>(vb); L[5] = tr_read<v_rd_off<NC>(2, KS, 1)>(vb); L[6] = tr_read<v_rd_off<NC>(3, KS, 0)>(vb); L[7] = tr_read<v_rd_off<NC>(3, KS, 1)>(vb); }
}
template <int NC> __device__ __forceinline__ void v_mma_k(f32x16* o, f32x16& osum, const s16x4 (&L)[8], bf16x8 pa, bf16x8 ones) {
#define PK(A, B) (bf16x8){A[0], A[1], A[2], A[3], B[0], B[1], B[2], B[3]}
  osum = __builtin_amdgcn_mfma_f32_32x32x16_bf16(pa, ones, osum, 0, 0, 0);
  o[0] = __builtin_amdgcn_mfma_f32_32x32x16_bf16(pa, PK(L[0], L[1]), o[0], 0, 0, 0);
  o[1] = __builtin_amdgcn_mfma_f32_32x32x16_bf16(pa, PK(L[2], L[3]), o[1], 0, 0, 0);
  if constexpr (NC == 4) { o[2] = __builtin_amdgcn_mfma_f32_32x32x16_bf16(pa, PK(L[4], L[5]), o[2], 0, 0, 0); o[3] = __builtin_amdgcn_mfma_f32_32x32x16_bf16(pa, PK(L[6], L[7]), o[3], 0, 0, 0); }
#undef PK
}
template <int DV, bool NA>
__device__ __forceinline__ void attn_core(const bf16_t* __restrict__ Qlane, const bf16_t* __restrict__ Kh, const bf16_t* __restrict__ Vh, const int NT,
                                          ALAS char* lds, f32x16 (&o)[DV / 32], const NaCtx& na) {
  constexpr int NC = DV / 32;
  int tid_ = threadIdx.x; asm volatile("" : "+v"(tid_));
  const int tid = tid_, wid = __builtin_amdgcn_readfirstlane(tid >> 6), lane = tid & 63, r32 = lane & 31, hi = lane >> 5;
  ALAS char* V_lds = lds + L_V; ALAS char* K_lds = lds + L_K;
  ALAS float* al_l = (ALAS float*)(lds + L_WS) + wid * 64;
  float m_ref = 0.f;
  f32x16 osum = f32x16{}, negm = f32x16{};
#pragma unroll
  for (int d = 0; d < NC; ++d) o[d] = f32x16{};
  bf16x8 qr[4];
#pragma unroll
  for (int d0 = 0; d0 < 4; ++d0) qr[d0] = *reinterpret_cast<const bf16x8*>(Qlane + d0 * 16);
  const bf16x8 ones = {0x3f80, 0x3f80, 0x3f80, 0x3f80, 0x3f80, 0x3f80, 0x3f80, 0x3f80};
  const int kr_ = tid >> 3, kc8 = (tid & 7) * 8, kst = KSWZ(kr_, kc8 * 2);
  const int vr_ = (DV == 128) ? (tid >> 4) : (tid >> 3), vc8 = (DV == 128) ? (tid & 15) * 8 : (tid & 7) * 8;
  const int vst0 = v_st<NC>(vr_, vc8), vst1 = v_st<NC>((32 + vr_) & 63, vc8);
  const int vb0 = (int)(uintptr_t)V_lds + v_rd_base(lane);
  const int kgo = kr_ * LD + kc8, vgo = vr_ * LD + vc8;
  bf16x8 sk0, sva0, svb0, sk1, sva1, svb1;
#define SLOADX(S, k0) do { sk##S = *reinterpret_cast<const bf16x8*>(Kh + (long)(k0) * LD + kgo); sva##S = *reinterpret_cast<const bf16x8*>(Vh + (long)(k0) * LD + vgo); \
    if constexpr (DV == 128) svb##S = *reinterpret_cast<const bf16x8*>(Vh + (long)((k0) + 32) * LD + vgo); } while (0)
#define SWRITEX(S, b) do { *(ALAS bf16x8*)(V_lds + (b) * SHM_V + vst0) = sva##S; if constexpr (DV == 128) *(ALAS bf16x8*)(V_lds + (b) * SHM_V + vst1) = svb##S; \
    *(ALAS bf16x8*)(K_lds + (b) * SHM_K + kst) = sk##S; } while (0)
#define ACT(t) (!NA || ((na.klo + (t)) >= na.s0q && (na.klo + (t)) <= na.s0q + 7))
  SLOADX(0, 0); asm volatile("s_waitcnt vmcnt(0)" ::: "memory"); SWRITEX(0, 0); SLOADX(1, 64); SLOADX(0, 128); __syncthreads();
  for (int jj = 0; jj < NT; jj += 2) {
#pragma unroll
   for (int par = 0; par < 2; ++par) {
    const int j = jj + par; const int b = par; const bool act = ACT(j);
    bf16x8 kf[8];
    if (act) k_issue(kf, K_lds + b * SHM_K, r32, hi);
    if (par == 0) { if (j + 1 < NT) { SWRITEX(1, 1); if (j + 3 < NT) SLOADX(1, (j + 3) * 64); } }
    else          { if (j + 1 < NT) { SWRITEX(0, 0); if (j + 3 < NT) SLOADX(0, (j + 3) * 64); } }
    if (act) {
      f32x16 p0, p1;
      qkt(p0, p1, kf, qr, negm);
      if constexpr (NA) na_bias(p0, p1, j, hi, na);
      float pmax = fmaxf(p0[0], p1[0]), pmx2 = fmaxf(p0[1], p1[1]);
#pragma unroll
      for (int r = 2; r < 16; r += 2) { pmax = __builtin_fmaxf(__builtin_fmaxf(pmax, p0[r]), p1[r]); pmx2 = __builtin_fmaxf(__builtin_fmaxf(pmx2, p0[r + 1]), p1[r + 1]); }
      pmax = fmaxf(pmax, pmx2);
      { auto rr = __builtin_amdgcn_permlane32_swap(__float_as_uint(pmax), __float_as_uint(pmax), false, false);
        pmax = fmaxf(__uint_as_float(rr[0]), __uint_as_float(rr[1])); }
      if (__builtin_expect(!__all(pmax <= THR2), 0)) {
        const float dl = fmaxf(pmax, 0.f); m_ref += dl;
#pragma unroll
        for (int r = 0; r < 16; ++r) { p0[r] -= dl; p1[r] -= dl; negm[r] = -m_ref; }
        const float f = __builtin_amdgcn_exp2f(-dl);
        if (hi == 0) al_l[r32] = f; asm volatile("s_waitcnt lgkmcnt(0)" ::: "memory");
#pragma unroll
        for (int r = 0; r < 16; ++r) { const float ar = al_l[crow(r, hi)]; osum[r] *= ar;
#pragma unroll
          for (int d = 0; d < NC; ++d) o[d][r] *= ar; }
      }
      const int vb = vb0 + b * SHM_V;
      s16x4 LA[8], LB[8]; bf16x8 pa;
#define PK4(P, BASE, OUT) do { unsigned a0 = cvtpk(P[BASE + 0], P[BASE + 1]), a1 = cvtpk(P[BASE + 2], P[BASE + 3]);   \
    unsigned b0 = cvtpk(P[BASE + 4], P[BASE + 5]), b1 = cvtpk(P[BASE + 6], P[BASE + 7]);                              \
    auto r0 = __builtin_amdgcn_permlane32_swap(a0, b0, false, false); auto r1 = __builtin_amdgcn_permlane32_swap(a1, b1, false, false); \
    u32x4 w = {r0[0], r1[0], r0[1], r1[1]}; OUT = *reinterpret_cast<bf16x8*>(&w); } while (0)
#define EXP8(P, BASE) do { _Pragma("unroll") for (int r = 0; r < 8; ++r) P[BASE + r] = __builtin_amdgcn_exp2f(P[BASE + r]); } while (0)
#define LGKM(n) asm volatile("s_waitcnt lgkmcnt(" #n ")" ::: "memory")
      v_issue_k<NC, 0>(LA, vb);
      EXP8(p0, 0); PK4(p0, 0, pa); SBAR();
      v_issue_k<NC, 1>(LB, vb); if constexpr (NC == 4) LGKM(8); else LGKM(4); SBAR(); v_mma_k<NC>(o, osum, LA, pa, ones); SBAR();
      EXP8(p0, 8); PK4(p0, 8, pa); SBAR();
      v_issue_k<NC, 2>(LA, vb); if constexpr (NC == 4) LGKM(8); else LGKM(4); SBAR(); v_mma_k<NC>(o, osum, LB, pa, ones); SBAR();
      EXP8(p1, 0); PK4(p1, 0, pa); SBAR();
      v_issue_k<NC, 3>(LB, vb); if constexpr (NC == 4) LGKM(8); else LGKM(4); SBAR(); v_mma_k<NC>(o, osum, LA, pa, ones); SBAR();
      EXP8(p1, 8); PK4(p1, 8, pa); SBAR();
      LGKM(0); SBAR(); v_mma_k<NC>(o, osum, LB, pa, ones);
#undef PK4
#undef EXP8
#undef LGKM
    }
    __syncthreads();
   }
  }
#pragma unroll
  for (int r = 0; r < 16; ++r) { const float rl = __builtin_amdgcn_rcpf(osum[r]);
#pragma unroll
    for (int d = 0; d < NC; ++d) o[d][r] *= rl; }
#undef SLOADX
#undef SWRITEX
#undef ACT
}
__device__ __forceinline__ bf16_t to_bf16(float v) { return (bf16_t)(cvtpk(v, 0.f) & 0xffffu); }

constexpr int NAW_V = 0, NAW_TAB = 131072, NAW_TSTRIDE = 2000, NAW_END = NAW_TAB + 8 * NAW_TSTRIDE;
__device__ __forceinline__ void na_wave_units(int gw, int NGW, const bf16_t* QA, bf16_t* AB, const float* rpb  , ALAS char* lds) {
  int tid_ = threadIdx.x; asm volatile("" : "+v"(tid_));
  const int tid = tid_, wid = __builtin_amdgcn_readfirstlane(tid >> 6), lane = tid & 63, r32 = lane & 31, hi = lane >> 5;
  const int h = gw & 7;
  ALAS char* Vw = lds + NAW_V + wid * 16384;
  ALAS float* tab = (ALAS float*)(lds + NAW_TAB + wid * NAW_TSTRIDE);
  for (int i = lane; i < 480; i += 64) { const int dr = i >> 5, dc = i & 31; tab[i] = (dc < 31) ? rpb[(h * 15 + dr) * 31 + dc] * 1.4426950408889634f : 0.f; }
  asm volatile("s_waitcnt lgkmcnt(0)" ::: "memory");
  const bf16x8 ones = {0x3f80, 0x3f80, 0x3f80, 0x3f80, 0x3f80, 0x3f80, 0x3f80, 0x3f80};
  const int vb0 = (int)(uintptr_t)Vw + v_rd_base(lane);
  int vgo[8], vso[8];
#pragma unroll
  for (int i = 0; i < 8; ++i) { const int p = i * 64 + lane, key = p >> 3, c8 = (p & 7) * 8; vgo[i] = key * LD + c8; vso[i] = v_st<2>(key, c8); }
  const int kgo0 = r32 * LD + hi * 8, kgo1 = (32 + r32) * LD + hi * 8;
  for (int wu = gw; wu < 20480; wu += NGW) {
    const int hf = (wu >> 3) & 1, rowg = wu >> 4;
    int base, r, rows;
    if (rowg < 256) { base = 0; r = rowg; rows = 256; } else { const int l = rowg - 256; base = 16384 + (l >> 6) * 4096; r = l & 63; rows = 64; }
    NaCtx c; c.s0q = min(max(r - 4, 0), rows - 8); c.klo = c.s0q; c.rq = r; c.qc = 32 * hf + r32; c.wstart = min(max(c.qc - 8, 0), 48); c.tab = tab;
    const long qrow = (long)base + r * 64 + hf * 32;
    const bf16_t* Qlane = QA + (qrow + r32) * LD + h * 64 + hi * 8;
    const bf16_t* Kb = QA + ((long)base + c.klo * 64) * LD + 512 + h * 64;
    const bf16_t* Vb = QA + ((long)base + c.klo * 64) * LD + 1024 + h * 64;
    bf16x8 qr[4];
#pragma unroll
    for (int d0 = 0; d0 < 4; ++d0) qr[d0] = *reinterpret_cast<const bf16x8*>(Qlane + d0 * 16);
    float m_ref = 0.f; f32x16 osum = f32x16{}, negm = f32x16{}, o[2]; o[0] = f32x16{}; o[1] = f32x16{};
    bf16x8 kf[8], vN[8];
#define KLOAD(t) do { _Pragma("unroll") for (int d0 = 0; d0 < 4; ++d0) { kf[2 * d0] = *reinterpret_cast<const bf16x8*>(Kb + (long)(t) * 64 * LD + kgo0 + d0 * 16); \
                                                                        kf[2 * d0 + 1] = *reinterpret_cast<const bf16x8*>(Kb + (long)(t) * 64 * LD + kgo1 + d0 * 16); } } while (0)
#define VLOAD(t) do { _Pragma("unroll") for (int i = 0; i < 8; ++i) vN[i] = *reinterpret_cast<const bf16x8*>(Vb + (long)(t) * 64 * LD + vgo[i]); } while (0)
#define VWRITE(b) do { _Pragma("unroll") for (int i = 0; i < 8; ++i) *(ALAS bf16x8*)(Vw + (b) * 8192 + vso[i]) = vN[i]; } while (0)
    KLOAD(0); VLOAD(0); VWRITE(0);
#pragma unroll
    for (int t = 0; t < 8; ++t) {
      const int b = t & 1;
      if (t + 1 < 8) VLOAD(t + 1);
      f32x16 p0, p1;
      qkt(p0, p1, kf, qr, negm);
      if (t + 1 < 8) { asm volatile("" ::: "memory"); KLOAD(t + 1); }
      na_bias(p0, p1, t, hi, c);
      float pmax = fmaxf(p0[0], p1[0]), pmx2 = fmaxf(p0[1], p1[1]);
#pragma unroll
      for (int q = 2; q < 16; q += 2) { pmax = __builtin_fmaxf(__builtin_fmaxf(pmax, p0[q]), p1[q]); pmx2 = __builtin_fmaxf(__builtin_fmaxf(pmx2, p0[q + 1]), p1[q + 1]); }
      pmax = fmaxf(pmax, pmx2);
      { auto rr = __builtin_amdgcn_permlane32_swap(__float_as_uint(pmax), __float_as_uint(pmax), false, false); pmax = fmaxf(__uint_as_float(rr[0]), __uint_as_float(rr[1])); }
      if (__builtin_expect(!__all(pmax <= THR2), 0)) {
        const float dl = fmaxf(pmax, 0.f); m_ref += dl;
#pragma unroll
        for (int q = 0; q < 16; ++q) { p0[q] -= dl; p1[q] -= dl; negm[q] = -m_ref; }
        const float f = __builtin_amdgcn_exp2f(-dl);
#pragma unroll
        for (int q = 0; q < 16; ++q) { const float ar = __shfl(f, crow(q, hi), 64); osum[q] *= ar; o[0][q] *= ar; o[1][q] *= ar; }
      }
#pragma unroll
      for (int q = 0; q < 16; ++q) { p0[q] = __builtin_amdgcn_exp2f(p0[q]); p1[q] = __builtin_amdgcn_exp2f(p1[q]); }
      bf16x8 pa0, pa1, pa2, pa3;
#define PK4(P, BASE, OUT) do { unsigned a0 = cvtpk(P[BASE + 0], P[BASE + 1]), a1 = cvtpk(P[BASE + 2], P[BASE + 3]);   \
    unsigned b0 = cvtpk(P[BASE + 4], P[BASE + 5]), b1 = cvtpk(P[BASE + 6], P[BASE + 7]);                              \
    auto r0 = __builtin_amdgcn_permlane32_swap(a0, b0, false, false); auto r1 = __builtin_amdgcn_permlane32_swap(a1, b1, false, false); \
    u32x4 w = {r0[0], r1[0], r0[1], r1[1]}; OUT = *reinterpret_cast<bf16x8*>(&w); } while (0)
      PK4(p0, 0, pa0); PK4(p0, 8, pa1); PK4(p1, 0, pa2); PK4(p1, 8, pa3);
#undef PK4
      { const int vb = vb0 + b * 8192; s16x4 LA[8], LB[8];
        v_issue_k<2, 0>(LA, vb); v_issue_k<2, 1>(LB, vb); asm volatile("s_waitcnt lgkmcnt(4)" ::: "memory"); SBAR(); v_mma_k<2>(o, osum, LA, pa0, ones); SBAR();
        v_issue_k<2, 2>(LA, vb); asm volatile("s_waitcnt lgkmcnt(4)" ::: "memory"); SBAR(); v_mma_k<2>(o, osum, LB, pa1, ones); SBAR();
        v_issue_k<2, 3>(LB, vb); asm volatile("s_waitcnt lgkmcnt(4)" ::: "memory"); SBAR(); v_mma_k<2>(o, osum, LA, pa2, ones); SBAR();
        asm volatile("s_waitcnt lgkmcnt(0)" ::: "memory"); SBAR(); v_mma_k<2>(o, osum, LB, pa3, ones); }
      if (t + 1 < 8) VWRITE(b ^ 1);
    }
#undef KLOAD
#undef VLOAD
#undef VWRITE
    bf16_t* Ow = AB + qrow * 1024 + h * 64 + r32;
#pragma unroll
    for (int q = 0; q < 16; ++q) { const float rl = __builtin_amdgcn_rcpf(osum[q]); const int orow = crow(q, hi);
      Ow[(long)orow * 1024] = to_bf16(o[0][q] * rl); Ow[(long)orow * 1024 + 32] = to_bf16(o[1][q] * rl); }
    asm volatile("s_waitcnt lgkmcnt(0)" ::: "memory");
  }
}
__device__ __forceinline__ void diff_unit(int base, int seq, int h, int qblk, const bf16_t* QB, bf16_t* AB, float lam, float one_m_li, const float* subln, ALAS char* lds) {
  int tid_ = threadIdx.x; asm volatile("" : "+v"(tid_));
  const int tid = tid_, wid = __builtin_amdgcn_readfirstlane(tid >> 6), lane = tid & 63, r32 = lane & 31, hi = lane >> 5;
  const int row0 = base + qblk * 256;
  ALAS unsigned* stash = (ALAS unsigned*)(lds + L_STASH) + wid * 2048;
  NaCtx c{};
  f32x16 o[4];
  for (int mp = 0; mp < 2; ++mp) {
    const bf16_t* Qlane = QB + (long)(row0 + wid * 32 + r32) * LD + h * 128 + mp * 64 + hi * 8;
    const bf16_t* Kh = QB + (long)base * LD + 512 + h * 128 + mp * 64;
    const bf16_t* Vh = QB + (long)base * LD + 1024 + h * 128;
    attn_core<128, false>(Qlane, Kh, Vh, seq >> 6, lds, o, c);
    if (mp == 0) {
#pragma unroll
      for (int d0 = 0; d0 < 4; ++d0)
#pragma unroll
        for (int r = 0; r < 16; r += 2) stash[(d0 * 8 + (r >> 1)) * 64 + lane] = cvtpk(o[d0][r], o[d0][r + 1]);
    }
  }
  asm volatile("s_waitcnt lgkmcnt(0)" ::: "memory");
  float sg[4];
#pragma unroll
  for (int d0 = 0; d0 < 4; ++d0) sg[d0] = subln[d0 * 32 + r32] * one_m_li;
  bf16_t* Ow = AB + (long)(row0 + wid * 32) * 1024 + 512 + h * 128 + r32;
#pragma unroll
  for (int r = 0; r < 16; r += 2) {
    float v0[4], v1[4]; float s0 = 0.f, s1 = 0.f;
#pragma unroll
    for (int d0 = 0; d0 < 4; ++d0) { const unsigned w = stash[(d0 * 8 + (r >> 1)) * 64 + lane];
      v0[d0] = __uint_as_float(w << 16) - lam * o[d0][r]; v1[d0] = __uint_as_float(w & 0xffff0000u) - lam * o[d0][r + 1];
      s0 += v0[d0] * v0[d0]; s1 += v1[d0] * v1[d0]; }
#pragma unroll
    for (int x = 1; x < 32; x <<= 1) { s0 += __shfl_xor(s0, x); s1 += __shfl_xor(s1, x); }
    const float rs0 = __builtin_amdgcn_rsqf(s0 * (1.0f / 128.0f) + 1e-5f), rs1 = __builtin_amdgcn_rsqf(s1 * (1.0f / 128.0f) + 1e-5f);
    const int or0 = crow(r, hi), or1 = crow(r + 1, hi);
#pragma unroll
    for (int d0 = 0; d0 < 4; ++d0) { Ow[(long)or0 * 1024 + d0 * 32] = to_bf16(v0[d0] * rs0 * sg[d0]); Ow[(long)or1 * 1024 + d0 * 32] = to_bf16(v1[d0] * rs1 * sg[d0]); }
  }
}
#undef SBAR
}
#define LAS __attribute__((address_space(3)))
typedef unsigned short bf16;
typedef unsigned v4u __attribute__((ext_vector_type(4)));
typedef unsigned v2u __attribute__((ext_vector_type(2)));
typedef float f32x4 __attribute__((ext_vector_type(4)));
constexpr int NWAVES = 8;
constexpr int MTOK = 81920, NP = 16384, DM = 1024, DFF = 2816, NLAYER = 2;
constexpr size_t MiB = 1u << 20;
constexpr size_t WS_GNH = 64 * 1024;
constexpr size_t WS_RPB = 128 * 1024, WS_SUB = 192 * 1024, WS_LAM = 200 * 1024;
constexpr size_t WS_ROPE = 1 * MiB;
constexpr size_t WS_W = 4 * MiB, WS_WL = 48 * MiB;
constexpr size_t WS_H = 104 * MiB;
constexpr size_t WS_R = 264 * MiB;
constexpr size_t WS_T = WS_R;
constexpr size_t WS_QA = WS_R, WS_QB = WS_R + 240 * MiB, WS_AB = WS_R + 480 * MiB;
constexpr size_t WS_G = WS_R, WS_MG = WS_R + 320 * MiB;
constexpr size_t WS_SS = WS_R + 640 * MiB;
constexpr size_t WS_END = WS_SS + 6 * MiB;
constexpr size_t WO_WI1 = 0, WO_WO1 = WO_WI1 + (size_t)5632 * 1024, WO_QKV = WO_WO1 + (size_t)1024 * 2816, WO_G = WO_QKV + (size_t)3072 * 1024,
                 WO_AB = WO_G + (size_t)2048 * 1024, WO_OUT = WO_AB + (size_t)1024 * 1024, WO_WI2 = WO_OUT + (size_t)1024 * 1024, WO_WO2 = WO_WI2 + (size_t)5632 * 1024,
                 WO_END = WO_WO2 + (size_t)1024 * 2816;
static_assert(WO_END * 2 <= WS_WL, "weight block");
constexpr int RING_BYTES = 131072, LDS_BYTES = 147456;
static_assert(att::L_END <= LDS_BYTES && att::NAW_END <= LDS_BYTES - 64, "attention LDS");

#define LDS_WAIT() asm volatile("s_waitcnt lgkmcnt(0)" ::: "memory")
__device__ __forceinline__ unsigned f2bf(float f) { unsigned u = __builtin_bit_cast(unsigned, f); return (u + 0x7fffu + ((u >> 16) & 1u)) >> 16; }
__device__ __forceinline__ unsigned pk2(float lo, float hi) { return f2bf(lo) | (f2bf(hi) << 16); }
__device__ __forceinline__ float wave_sum(float v) {
#pragma unroll
    for (int o = 1; o < 64; o <<= 1) v += __shfl_xor(v, o);
    return v;
}
__device__ __forceinline__ void tr_item(const float* W, int N, int k0, int n0, bf16* dst, int drow0, int ldd, int koff, LAS float* scr, int lane, const float* g = nullptr) {
    {   const int kr = lane >> 3, c4 = (lane & 7) * 4;
        f32x4 wv[8];
#pragma unroll
        for (int i = 0; i < 8; ++i) wv[i] = *(const f32x4*)(W + (size_t)(k0 + i * 8 + kr) * N + n0 + c4);
#pragma unroll
        for (int i = 0; i < 8; ++i) { const int kk = i * 8 + kr; const float gk = g ? g[k0 + kk] : 1.0f; LAS float* d = scr + kk * 33 + c4;
            d[0] = wv[i][0] * gk; d[1] = wv[i][1] * gk; d[2] = wv[i][2] * gk; d[3] = wv[i][3] * gk; } }
    LDS_WAIT(); asm volatile("" ::: "memory");
    const int c = lane & 7;
#pragma unroll
    for (int j = 0; j < 4; ++j) { const int n = (lane >> 3) + 8 * j; const LAS float* s = scr + (8 * c) * 33 + n;
        v4u o; o.x = pk2(s[0 * 33], s[1 * 33]); o.y = pk2(s[2 * 33], s[3 * 33]); o.z = pk2(s[4 * 33], s[5 * 33]); o.w = pk2(s[6 * 33], s[7 * 33]);
        *(v4u*)(dst + (size_t)(drow0 + n) * ldd + koff + k0 + 8 * c) = o; }
    LDS_WAIT(); asm volatile("" ::: "memory");
}
__device__ __forceinline__ void xb_row2(const float* xa, const float* xb_, bf16* oa, bf16* ob, float* sa, float* sb, int lane) {
    const f32x4* ra = (const f32x4*)xa + lane; const f32x4* rb = (const f32x4*)xb_ + lane;
    f32x4 va[4], vb[4]; float s0 = 0.f, s1 = 0.f;
#pragma unroll
    for (int j = 0; j < 4; ++j) { va[j] = ra[64 * j]; vb[j] = rb[64 * j]; }
#pragma unroll
    for (int j = 0; j < 4; ++j) { s0 += (va[j].x * va[j].x + va[j].y * va[j].y) + (va[j].z * va[j].z + va[j].w * va[j].w); s1 += (vb[j].x * vb[j].x + vb[j].y * vb[j].y) + (vb[j].z * vb[j].z + vb[j].w * vb[j].w); }
#pragma unroll
    for (int o = 1; o < 64; o <<= 1) { s0 += __shfl_xor(s0, o); s1 += __shfl_xor(s1, o); }
    v2u* pa = (v2u*)oa + lane; v2u* pb = (v2u*)ob + lane;
#pragma unroll
    for (int j = 0; j < 4; ++j) { v2u w; w.x = pk2(va[j].x, va[j].y); w.y = pk2(va[j].z, va[j].w); pa[64 * j] = w; v2u z; z.x = pk2(vb[j].x, vb[j].y); z.y = pk2(vb[j].z, vb[j].w); pb[64 * j] = z; }
    if (lane < 16) { sa[lane] = (lane == 0) ? s0 : 0.f; sb[lane] = (lane == 0) ? s1 : 0.f; }
}
__device__ __forceinline__ void xb_row(const float* xrow, bf16* orow, float* ssrow, int lane) {
    const f32x4* xr = (const f32x4*)xrow + lane;
    f32x4 v[4]; float s = 0.f;
#pragma unroll
    for (int j = 0; j < 4; ++j) { v[j] = xr[64 * j]; s += (v[j].x * v[j].x + v[j].y * v[j].y) + (v[j].z * v[j].z + v[j].w * v[j].w); }
    s = wave_sum(s);
    v2u* o8 = (v2u*)orow + lane;
#pragma unroll
    for (int j = 0; j < 4; ++j) { v2u w; w.x = pk2(v[j].x, v[j].y); w.y = pk2(v[j].z, v[j].w); o8[64 * j] = w; }
    if (lane < 16) ssrow[lane] = (lane == 0) ? s : 0.f;
}

constexpr size_t WS_BAR = 256 * 1024;
#define RLX_AGENT __ATOMIC_RELAXED, __HIP_MEMORY_SCOPE_AGENT
#define XB_TMO      128
#define XB_XCNT(j)  (256  + 64 * (j))
#define XB_XSUB(j)  (1280 + 64 * (j))
#define XB_XGEN(j)  (2304 + 64 * (j))
#define XB_TOP      3328
#define XB_TOPGEN   3392
#define XCD_BAR_WORDS 3456
#define XB_SPIN_CAP (1u << 18)

__device__ __forceinline__ unsigned xb_ld(unsigned* p)              { return __hip_atomic_load(p, __ATOMIC_RELAXED, __HIP_MEMORY_SCOPE_AGENT); }
__device__ __forceinline__ unsigned xb_add(unsigned* p, unsigned v) { return __hip_atomic_fetch_add(p, v, __ATOMIC_RELAXED, __HIP_MEMORY_SCOPE_AGENT); }
__device__ __forceinline__ unsigned xb_xcc_id() { return (unsigned)__builtin_amdgcn_s_getreg((3 << 11) | 20) & 0xFu; }
#define XB_SPIN(cond, bar) do { unsigned _sp = 0; while (cond) { __builtin_amdgcn_s_sleep(1); \
    if ((++_sp & 255u) == 0u) { if (xb_ld(&(bar)[XB_TMO])) break; if (_sp > XB_SPIN_CAP) { atomicAdd(&(bar)[XB_TMO], 1u); break; } } } } while (0)

struct XcdBarrier {
    unsigned* bar; unsigned x;
    volatile LAS unsigned* st;
};

__device__ __forceinline__ XcdBarrier xcd_barrier_post(unsigned* bar, volatile LAS unsigned* st) {
    XcdBarrier b; b.bar = bar; b.x = xb_xcc_id(); b.st = st;
    if (threadIdx.x == 0) (void)xb_add(&bar[XB_XCNT(b.x)], 1u);
    return b;
}
__device__ __forceinline__ void xcd_barrier_complete(unsigned* bar, unsigned x, unsigned& nloc, unsigned& nx) {
    const unsigned G = gridDim.x * gridDim.y * gridDim.z;
    unsigned sum, cnt, mine, sp = 0u;
    for (;;) {
        sum = 0u; cnt = 0u; mine = 0u;
#pragma unroll
        for (unsigned j = 0; j < 16; ++j) { const unsigned c = xb_ld(&bar[XB_XCNT(j)]); sum += c; cnt += (c > 0u) ? 1u : 0u; mine = (j == x) ? c : mine; }
        if (sum == G) break;
        __builtin_amdgcn_s_sleep(1);
        if ((++sp & 255u) == 0u) { if (xb_ld(&bar[XB_TMO])) break; if (sp > XB_SPIN_CAP) { atomicAdd(&bar[XB_TMO], 1u); break; } }
    }
    nloc = mine > 0u ? mine : 1u; nx = cnt > 0u ? cnt : 1u;
}

__device__ __forceinline__ void xcd_barrier(const XcdBarrier& b) {
    asm volatile("s_waitcnt vmcnt(0)" ::: "memory");
    __syncthreads();
    if (threadIdx.x == 0) {
        unsigned* bar = b.bar;
        __builtin_amdgcn_s_waitcnt(0);
        unsigned nloc = b.st[0], nx = b.st[1];
        if (nloc == 0u) { xcd_barrier_complete(bar, b.x, nloc, nx); b.st[0] = nloc; b.st[1] = nx; }
        const unsigned old = xb_add(&bar[XB_XSUB(b.x)], 1u);
        const unsigned gen = old / nloc;
        if (old + 1u == (gen + 1u) * nloc) {
            __builtin_amdgcn_fence(__ATOMIC_RELEASE, "agent");
            asm volatile("s_waitcnt vmcnt(0)" ::: "memory");
            const unsigned og = xb_add(&bar[XB_TOP], 1u);
            const unsigned tg = og / nx;
            if (og + 1u == (tg + 1u) * nx) xb_add(&bar[XB_TOPGEN], 1u);
            else XB_SPIN(xb_ld(&bar[XB_TOPGEN]) == tg, bar);
            __builtin_amdgcn_fence(__ATOMIC_ACQUIRE, "agent");
            xb_add(&bar[XB_XGEN(b.x)], 1u);
            asm volatile("s_waitcnt vmcnt(0)" ::: "memory");
        } else {
            XB_SPIN(xb_ld(&bar[XB_XGEN(b.x)]) == gen, bar);
            __builtin_amdgcn_fence(__ATOMIC_ACQUIRE, "agent");
            asm volatile("s_waitcnt vmcnt(0)" ::: "memory");
        }
    }
    __syncthreads();
}

#define GSYNC() xcd_barrier(xbar)
struct Args { const float* in[23]; float* out; unsigned char* ws; };

__global__ void __launch_bounds__(NWAVES * 64, 2) mega_fwd(Args a) {
    extern __shared__ __attribute__((aligned(16))) unsigned char lds_raw[];
    cg::grid_group grid = cg::this_grid();
    LAS unsigned char* lds = (LAS unsigned char*)lds_raw;
    const int tid = threadIdx.x, lane = tid & 63, wave = __builtin_amdgcn_readfirstlane(tid >> 6);
    const int G = gridDim.x, bx = blockIdx.x;
    const int vcu = (G % 8 == 0) ? (bx % 8) * (G / 8) + bx / 8 : bx;
    const int gw = vcu * NWAVES + wave, NGW = G * NWAVES;
    unsigned char* ws = a.ws;
    volatile LAS unsigned* xb_st = (volatile LAS unsigned*)(lds + LDS_BYTES - 64);
    if (tid < 2) xb_st[tid] = 0u;
    __syncthreads();
    const XcdBarrier xbar = xcd_barrier_post((unsigned*)(ws + WS_BAR), xb_st);
    float* xbuf = a.out;
    bf16* Hb = (bf16*)(ws + WS_H); bf16* Tb = (bf16*)(ws + WS_T); bf16* QAb = (bf16*)(ws + WS_QA); bf16* QBb = (bf16*)(ws + WS_QB);
    bf16* ABb = (bf16*)(ws + WS_AB); bf16* Gb = (bf16*)(ws + WS_G); bf16* MGb = (bf16*)(ws + WS_MG); float* rope = (float*)(ws + WS_ROPE); float* SSb = (float*)(ws + WS_SS); float* gnh = (float*)(ws + WS_GNH); float* rpbw = (float*)(ws + WS_RPB); float* subw = (float*)(ws + WS_SUB); float* lamw = (float*)(ws + WS_LAM);

    {
        LAS float* scr = (LAS float*)(lds + wave * 16384);
        constexpr int I0 = 16 * 176, I1 = 44 * 32, I2 = 16 * 160, I3 = 8 * 32, I4 = 8 * 32, I5 = 16 * 32, I6 = I0, I7 = I1;
        constexpr int NI = I0 + I1 + I2 + I3 + I4 + I5 + I6 + I7;
        for (int it = gw; it < NLAYER * NI; it += NGW) {
            const int l = it / NI; int r = it % NI;
            bf16* wl = (bf16*)(ws + WS_W + (size_t)l * WS_WL);
            if (r < I0 || (r >= I0 + I1 + I2 + I3 + I4 + I5 && r < NI - I7)) {
                const bool second = r >= I0; if (second) r -= I0 + I1 + I2 + I3 + I4 + I5;
                const float* W = a.in[second ? 21 : 3] + (size_t)l * 1024 * 5632;
                const int kb = r / 176, nb = r % 176, n0 = nb * 32; const int bj = n0 >= 2816, j = n0 - bj * 2816;
                tr_item(W, 5632, kb * 64, n0, wl + (second ? WO_WI2 : WO_WI1), 256 * (j >> 7) + 128 * bj + (j & 127), 1024, 0, scr, lane, a.in[second ? 20 : 2] + (size_t)l * DM);
                continue;
            }
            if (r >= NI - I7) { r -= NI - I7; const float* W = a.in[22] + (size_t)l * 2816 * 1024; const int kb = r / 32, nb = r % 32;
                tr_item(W, 1024, kb * 64, nb * 32, wl + WO_WO2, nb * 32, 2816, 0, scr, lane); continue; }
            r -= I0;
            if (r < I1) { const float* W = a.in[4] + (size_t)l * 2816 * 1024; const int kb = r / 32, nb = r % 32;
                tr_item(W, 1024, kb * 64, nb * 32, wl + WO_WO1, nb * 32, 2816, 0, scr, lane); continue; }
            r -= I1;
            if (r < I2) { const float* W = a.in[6] + (size_t)l * 1024 * 5120; const int kb = r / 160, nb = r % 160, n0 = nb * 32;
                if (n0 < 3072) { const int blk = n0 >> 8, o = n0 & 255, hh = o >> 6, bb = (o & 63) >> 5;
                    tr_item(W, 5120, kb * 64, n0, wl + WO_QKV, blk * 256 + 128 * bb + 32 * hh, 1024, 0, scr, lane, a.in[5] + (size_t)l * DM); }
                else { const int np = n0 - 3072, pb = np >= 1024, j = np - pb * 1024;
                    tr_item(W, 5120, kb * 64, n0, wl + WO_G, 256 * (j >> 7) + 128 * pb + (j & 127), 1024, 0, scr, lane, a.in[5] + (size_t)l * DM); }
                continue; }
            r -= I2;
            if (r < I3) { const float* W = a.in[17] + (size_t)l * 512 * 1024; const int kb = r / 32, nb = r % 32;
                tr_item(W, 1024, kb * 64, nb * 32, wl + WO_AB, nb * 32, 512, 0, scr, lane); continue; }
            r -= I3;
            if (r < I4) { const float* W = a.in[18] + (size_t)l * 512 * 1024; const int kb = r / 32, nb = r % 32;
                tr_item(W, 1024, kb * 64, nb * 32, wl + WO_AB, 1024 + nb * 32, 512, 0, scr, lane); continue; }
            r -= I4;
            { const float* W = a.in[19] + (size_t)l * 1024 * 1024; const int kb = r / 32, nb = r % 32;
                tr_item(W, 1024, kb * 64, nb * 32, wl + WO_OUT, nb * 32, 1024, 0, scr, lane); }
        }
        for (int mrow = gw; mrow < MTOK; mrow += 2 * NGW) {
            const int m2 = mrow + NGW;
            const float* xa = mrow < NP ? a.in[0] + (size_t)mrow * DM : a.in[1] + (size_t)(mrow - NP) * DM;
            if (m2 < MTOK) { const float* xb2 = m2 < NP ? a.in[0] + (size_t)m2 * DM : a.in[1] + (size_t)(m2 - NP) * DM;
                xb_row2(xa, xb2, Hb + (size_t)mrow * DM, Hb + (size_t)m2 * DM, SSb + (size_t)mrow * 16, SSb + (size_t)m2 * 16, lane); }
            else xb_row(xa, Hb + (size_t)mrow * DM, SSb + (size_t)mrow * 16, lane);
        }
        for (int idx = (vcu * NWAVES * 64 + tid); idx < NLAYER * 6 * 64; idx += G * NWAVES * 64) {
            const int l = idx / 384, p = (idx / 64) % 6, c = idx % 64;
            gnh[idx] = (p == 0) ? a.in[7][l * 64 + c] : (p == 1) ? a.in[8][l * 64 + c] : (p == 3) ? a.in[10][l * 64 + c] : (p == 4) ? a.in[11][l * 64 + c] : 1.0f;
        }
        for (int idx = (vcu * NWAVES * 64 + tid); idx < NLAYER * 3720; idx += G * NWAVES * 64) rpbw[idx] = a.in[9][idx];
        for (int idx = (vcu * NWAVES * 64 + tid); idx < NLAYER * 128; idx += G * NWAVES * 64) subw[idx] = a.in[16][idx];
        if (vcu == 0 && wave < NLAYER) { const int l = wave;
            const float s1 = wave_sum(a.in[12][l * 64 + lane] * a.in[13][l * 64 + lane]), s2 = wave_sum(a.in[14][l * 64 + lane] * a.in[15][l * 64 + lane]);
            if (lane == 0) lamw[l] = expf(s1) - expf(s2) + (0.8f - 0.6f * expf(-0.3f * (float)l)); }
        for (int idx = (vcu * NWAVES * 64 + tid); idx < NP * 8; idx += G * NWAVES * 64) {
            const int pos = idx >> 3, i = idx & 7;
            const float invf = (i == 0) ? 1.0f : (i == 1) ? 0.19392274474868576f : (i == 2) ? 0.03760603093086393f : (i == 3) ? 0.007292664737217109f :
                               (i == 4) ? 0.001414213562373095f : (i == 5) ? 0.0002742481756762073f : (i == 6) ? 5.318295896944988e-05f : 1.031338537721246e-05f;
            const float angf = (float)pos * invf;
            const double ang = (double)angf; const double k = __builtin_rint(ang * 0.15915494309189535); const double r = __builtin_fma(-k, 6.283185307179586, ang) - k * 2.4492935982947064e-16;
            const double x2 = r * r; double ts = 1.0, tc = 1.0, ss = 1.0, sc = 1.0;
#pragma unroll
            for (int q = 1; q <= 14; ++q) { tc = -tc * x2 * (1.0 / (double)((2 * q - 1) * (2 * q))); ts = -ts * x2 * (1.0 / (double)((2 * q) * (2 * q + 1))); sc += tc; ss += ts; }
            rope[pos * 16 + i] = (float)sc; rope[pos * 16 + 8 + i] = (float)(ss * r);
        }
    }
    GSYNC();
    grid.sync();

    float lam = 0.f, one_m_li = 1.f;
    for (int ph = 0; ph < NLAYER * 9; ++ph) {
        const int l = ph / 9, k = ph % 9;
        const bf16* wl = (const bf16*)(ws + WS_W + (size_t)l * WS_WL);
        const bool first_x = (ph == 1);
        if (k == 0 || k == 7) {
            pg8::Gemm g{Hb, wl + (k == 0 ? WO_WI1 : WO_WI2), MTOK, 5632, 1024}; pg8::StaticOrder S; S.init(MTOK, 5632, G, bx, ph & 1);
            pg8::EpiSwiglu E{Tb, SSb};
            pg8::gemm_phase<pg8::EpiSwiglu, pg8::StaticOrder, true, true>(lds, g, S, E);
        } else if (k == 1 || k == 6 || k == 8) {
            pg8::Gemm g{k == 6 ? MGb : Tb, wl + (k == 1 ? WO_WO1 : k == 6 ? WO_OUT : WO_WO2), MTOK, 1024, k == 6 ? 1024 : 2816}; pg8::StaticOrder S; S.init(MTOK, 1024, G, bx, ph & 1);
            pg8::EpiResid E{xbuf, k == 6 ? 1.0f : 0.5f, Hb, SSb, (ph == NLAYER * 9 - 1) ? 1 : 0};
            pg8::gemm_phase<pg8::EpiResid, pg8::StaticOrder, true, true>(lds, g, S, E);
        } else if (k == 2) {
            pg8::Gemm g{Hb, wl + WO_QKV, MTOK, 3072, 1024}; pg8::StaticOrder S; S.init(MTOK, 3072, G, bx, ph & 1);
            pg8::EpiQKV E{QAb, QBb, gnh + l * 384, rope, SSb};
            pg8::gemm_phase<pg8::EpiQKV, pg8::StaticOrder, true, true>(lds, g, S, E);
        } else if (k == 3) {
            const float li = 0.8f - 0.6f * expf(-0.3f * (float)l);
            lam = lamw[l]; one_m_li = 1.0f - li;
            const float* subln = subw + l * 128;
            for (int u = vcu; u < 256 + 1024; u += G) {
                if (u < 256) att::diff_unit(0, NP, u >> 6, u & 63, QBb, ABb, lam, one_m_li, subln, (LAS char*)lds);
                else { const int v = u - 256; att::diff_unit(NP + (v >> 6) * 4096, 4096, (v >> 4) & 3, v & 15, QBb, ABb, lam, one_m_li, subln, (LAS char*)lds); }
            }
            const float* rpb = rpbw + (size_t)l * 8 * 15 * 31;
            __syncthreads();
            att::na_wave_units(gw, NGW, QAb, ABb, rpb, (LAS char*)lds);
        } else if (k == 4) {
            pg8::Gemm g{ABb, wl + WO_AB, MTOK, 2048, 512, 1024, 1024}; pg8::StaticOrder S; S.init(MTOK, 2048, G, bx, ph & 1);
            pg8::EpiY E{Gb};
            pg8::gemm_phase<pg8::EpiY, pg8::StaticOrder, false, true>(lds, g, S, E);
        } else {
            pg8::Gemm g{Hb, wl + WO_G, MTOK, 2048, 1024}; pg8::StaticOrder S; S.init(MTOK, 2048, G, bx, ph & 1);
            pg8::EpiGateMerge E{Gb, MGb, SSb};
            pg8::gemm_phase<pg8::EpiGateMerge, pg8::StaticOrder, true, true>(lds, g, S, E);
        }
        if (ph != NLAYER * 9 - 1) GSYNC();
    }
}

extern "C" void kernel_launch(void* const* d_in, const int* in_sizes, int n_in, void* d_out, int out_size, void* d_ws, size_t ws_size, hipStream_t stream) {
    static int grid = 0;
    if (grid == 0) {
        if (n_in != 23 || out_size != MTOK * DM || ws_size < WS_END) { fprintf(stderr, "kernel_launch: unexpected shapes: n_in %d out %d ws %zu (need >= %zu)\n", n_in, out_size, ws_size, (size_t)WS_END); grid = -1; return; }
        int dev = 0, cus = 0, per_cu = 0;
        (void)hipGetDevice(&dev); (void)hipDeviceGetAttribute(&cus, hipDeviceAttributeMultiprocessorCount, dev);
        if (hipFuncSetAttribute((const void*)mega_fwd, hipFuncAttributeMaxDynamicSharedMemorySize, LDS_BYTES) != hipSuccess) { fprintf(stderr, "kernel_launch: hipFuncSetAttribute failed\n"); grid = -1; return; }
        if (hipOccupancyMaxActiveBlocksPerMultiprocessor(&per_cu, (const void*)mega_fwd, NWAVES * 64, LDS_BYTES) != hipSuccess || per_cu < 1) { fprintf(stderr, "kernel_launch: occupancy query says %d\n", per_cu); per_cu = 1; }
        (void)hipGetLastError();
        grid = cus * per_cu;
        fprintf(stderr, "kernel_launch: grid %d (cus %d x %d)\n", grid, cus, per_cu);
    }
    if (grid < 0) return;
    if (hipMemsetAsync((char*)d_ws + WS_BAR, 0, 16384, stream) != hipSuccess) { fprintf(stderr, "kernel_launch: memset failed\n"); return; }
    Args a{};
    for (int i = 0; i < 23; ++i) a.in[i] = (const float*)d_in[i];
    a.out = (float*)d_out; a.ws = (unsigned char*)d_ws;
    void* args[] = {&a};
    const hipError_t e = hipLaunchCooperativeKernel((const void*)mega_fwd, dim3(grid), dim3(NWAVES * 64), args, LDS_BYTES, stream);
    if (e != hipSuccess) fprintf(stderr, "kernel_launch: cooperative launch failed: %s (grid %d)\n", hipGetErrorString(e), grid);
}
```

```cpp
#include <hip/hip_runtime.h>
#include <hip/hip_cooperative_groups.h>
#include <cstdio>
#include <cstdint>
namespace cg = cooperative_groups;
namespace pg8 {
#define PG8_LAS __attribute__((address_space(3)))
typedef unsigned short bf16_t;
typedef short bf16x8 __attribute__((ext_vector_type(8)));
typedef float f32x4 __attribute__((ext_vector_type(4)));
typedef unsigned u32x4 __attribute__((ext_vector_type(4)));
constexpr int BM = 256, BK = 64, HALF = 128, HTB = HALF * BK * 2  , STAGE_BYTES = 8 * HTB, NXCD = 8, WGM = 8;

__host__ __device__ __forceinline__ int lds_byte(int r, int c) { const int st = (r >> 4) * 2 + (c >> 5), rr = r & 15, cc = c & 31, ob = rr * 64 + cc * 2; return st * 1024 + (ob ^ (((ob >> 9) & 1) << 5)); }
__host__ __device__ __forceinline__ void stage_rc(int b, int& R, int& C) { const int st = b / 1024, sb = b % 1024, swz = sb ^ (((sb >> 9) & 1) << 5); R = (st >> 1) * 16 + swz / 64; C = (st & 1) * 32 + (swz % 64) / 2; }
__host__ __device__ __forceinline__ int perm32(int rho) { const int n = rho >> 4, i = rho & 15; return 8 * (i >> 2) + 4 * n + (i & 3); }

struct Unit { int pm, pn; };
struct Gemm { const bf16_t* A; const bf16_t* Bt; int M, N, K; int lda = 0, aselb = 0; };

struct StaticOrder {
    int nM, nN, nwg, G, c, nr, rev;
    __host__ __device__ void init(int M, int N, int G_, int c_, int rev_ = 0) { nM = M / BM; nN = N / BM; nwg = nM * nN; G = G_; c = c_; rev = rev_; nr = (c < nwg) ? (nwg - c + G - 1) / G : 0; }
    __host__ __device__ bool next(int i, Unit& u) const {
        if (i >= nr) return false;
        const long L = (long)(rev ? nr - 1 - i : i) * G + c;
        int wgid = (int)L; { const int q = nwg / NXCD, r = nwg % NXCD, xcd = wgid % NXCD, off = wgid / NXCD; wgid = (xcd < r ? xcd * (q + 1) : r * (q + 1) + (xcd - r) * q) + off; }
        const int nig = WGM * nN, gid = wgid / nig, fm = gid * WGM, gsz = (nM - fm) < WGM ? (nM - fm) : WGM;
        u.pm = fm + ((wgid % nig) % gsz); u.pn = (wgid % nig) / gsz; return true;
    }
    __device__ __forceinline__ void a_ready(const Unit&) const {}
    __device__ __forceinline__ void done(const Unit&) const {}
};

typedef float f32x2c_ __attribute__((ext_vector_type(2))); typedef __bf16 bf16x2c_ __attribute__((ext_vector_type(2)));
__device__ __forceinline__ unsigned cvt_pk_bf16(float lo, float hi) { f32x2c_ v = {lo, hi}; bf16x2c_ b = __builtin_convertvector(v, bf16x2c_); return __builtin_bit_cast(unsigned, b); }
typedef float f32x2 __attribute__((ext_vector_type(2)));
typedef unsigned u32x2 __attribute__((ext_vector_type(2)));
constexpr int DM_ = 1024, DFF_ = 2816, LDQKV_ = 1536, LDG_ = 2048;
constexpr float LOG2E_ = 1.4426950408889634f;
constexpr float QSCALE_ = 0.125f * 1.4426950408889634f;
__device__ __forceinline__ float sigm(float x) { return __builtin_amdgcn_rcpf(1.f + __builtin_amdgcn_exp2f(-LOG2E_ * x)); }
__device__ __forceinline__ float bf_lo(unsigned w) { return __uint_as_float(w << 16); }
__device__ __forceinline__ float bf_hi(unsigned w) { return __uint_as_float(w & 0xffff0000u); }
__device__ __forceinline__ u32x4 pack8(const f32x4 a, const f32x4 b) { u32x4 w; w.x = cvt_pk_bf16(a[0], a[1]); w.y = cvt_pk_bf16(a[2], a[3]); w.z = cvt_pk_bf16(b[0], b[1]); w.w = cvt_pk_bf16(b[2], b[3]); return w; }


__device__ __forceinline__ float quad_sum(float s) {
    { auto r = __builtin_amdgcn_permlane16_swap(__float_as_uint(s), __float_as_uint(s), false, false); s = __uint_as_float(r[0]) + __uint_as_float(r[1]); }
    { auto r = __builtin_amdgcn_permlane32_swap(__float_as_uint(s), __float_as_uint(s), false, false); s = __uint_as_float(r[0]) + __uint_as_float(r[1]); }
    return s;
}
__device__ __forceinline__ void row_rstd(const float* SS, int row0, int fq, float (&rs)[2][4]) {
    f32x4 pv[2][4];
#pragma unroll
    for (int ai = 0; ai < 2; ++ai)
#pragma unroll
        for (int m = 0; m < 4; ++m) pv[ai][m] = *(const f32x4*)(SS + (size_t)(row0 + ai * HALF + m * 16) * 16 + 4 * fq);
#pragma unroll
    for (int ai = 0; ai < 2; ++ai)
#pragma unroll
        for (int m = 0; m < 4; ++m) { float s = (pv[ai][m][0] + pv[ai][m][1]) + (pv[ai][m][2] + pv[ai][m][3]); s = quad_sum(s);
            rs[ai][m] = __builtin_amdgcn_rsqf(s * (1.0f / 1024.0f) + 1e-6f); }
}

struct EpiSwiglu {
    static constexpr bool PERM = true, AFTER_DRAIN = false, MID = false;
    bf16_t* T; const float* SS;
    __device__ __forceinline__ void operator()(const f32x4 (&acc)[2][2][4][2], const Unit& u, int wr, int wc, int fr, int fq) const {
        const int row0 = u.pm * BM + wr * 64 + fr, col0 = u.pn * 128 + wc * 32 + 8 * fq;
        float rs[2][4]; row_rstd(SS, row0, fq, rs);
#pragma unroll
        for (int ai = 0; ai < 2; ++ai)
#pragma unroll
            for (int m = 0; m < 4; ++m) {
                bf16_t* rowp = T + (size_t)(row0 + ai * HALF + m * 16) * DFF_ + col0;
                f32x4 v[2];
#pragma unroll
                for (int n = 0; n < 2; ++n)
#pragma unroll
                    for (int i = 0; i < 4; ++i) { const float aa = acc[ai][0][m][n][i]; v[n][i] = (aa * acc[ai][1][m][n][i]) * (rs[ai][m] * rs[ai][m]) * __builtin_amdgcn_rcpf(1.f + __builtin_amdgcn_exp2f(aa * (rs[ai][m] * -LOG2E_))); }
                *(u32x4*)rowp = pack8(v[0], v[1]);
            }
    }
};
struct EpiResid {
    static constexpr bool PERM = true, AFTER_DRAIN = false, MID = false;
    float* xout; float s; bf16_t* XB; float* SS; int final_;
    __device__ __forceinline__ void operator()(const f32x4 (&acc)[2][2][4][2], const Unit& u, int wr, int wc, int fr, int fq) const {
        const int col0 = u.pn * BM + wc * 32 + 8 * fq;
        u32x4 xall[2][4][2];
#pragma unroll
        for (int ai = 0; ai < 2; ++ai)
#pragma unroll
            for (int m = 0; m < 4; ++m)
#pragma unroll
                for (int bj = 0; bj < 2; ++bj) xall[ai][m][bj] = *(const u32x4*)(XB + (size_t)(u.pm * BM + ai * HALF + wr * 64 + m * 16 + fr) * DM_ + col0 + bj * HALF);
#pragma unroll
        for (int ai = 0; ai < 2; ++ai)
#pragma unroll
            for (int m = 0; m < 4; ++m) {
                const int row = u.pm * BM + ai * HALF + wr * 64 + m * 16 + fr;
                const size_t off = (size_t)row * DM_ + col0;
                u32x4 xb[2];
#pragma unroll
                for (int bj = 0; bj < 2; ++bj) xb[bj] = xall[ai][m][bj];
                float ss = 0.f;
#pragma unroll
                for (int bj = 0; bj < 2; ++bj) {
                    f32x4 xv[2];
#pragma unroll
                    for (int w = 0; w < 4; ++w) { xv[w >> 1][(w & 1) * 2] = bf_lo(xb[bj][w]) + acc[ai][bj][m][w >> 1][(w & 1) * 2] * s; xv[w >> 1][(w & 1) * 2 + 1] = bf_hi(xb[bj][w]) + acc[ai][bj][m][w >> 1][(w & 1) * 2 + 1] * s; }
                    if (final_) { *(f32x4*)(xout + off + bj * HALF) = xv[0]; *(f32x4*)(xout + off + bj * HALF + 4) = xv[1]; }
                    else {
#pragma unroll
                        for (int n = 0; n < 2; ++n) ss += (xv[n][0] * xv[n][0] + xv[n][1] * xv[n][1]) + (xv[n][2] * xv[n][2] + xv[n][3] * xv[n][3]);
                        *(u32x4*)(XB + off + bj * HALF) = pack8(xv[0], xv[1]);
                    }
                }
                if (!final_) { ss = quad_sum(ss); if (fq == 0) SS[(size_t)row * 16 + u.pn * 4 + wc] = ss; }
                asm volatile("" ::: "memory");
            }
    }
};
struct EpiQKV {
    static constexpr bool PERM = true, AFTER_DRAIN = false, MID = false;
    bf16_t* QA; bf16_t* QB; const float* gn; const float* rope; const float* SS;
    __device__ __forceinline__ void operator()(const f32x4 (&acc)[2][2][4][2], const Unit& u, int wr, int wc, int fr, int fq) const {
        const int part = u.pn >> 1, sub = u.pn & 1, p3 = part % 3;
        bf16_t* dst = (part < 3) ? QA : QB;
        const int pcol = p3 * 512 + sub * 256 + wc * 64 + 8 * fq;
        const bool isqk = (p3 != 2), isq = (p3 == 0), dorope = (part >= 3) && isqk;
        const float* g = gn + part * 64;
        f32x4 gv[2][2];
#pragma unroll
        for (int bj = 0; bj < 2; ++bj)
#pragma unroll
            for (int n = 0; n < 2; ++n) gv[bj][n] = *(const f32x4*)(g + 32 * bj + 8 * fq + 4 * n);
        float rsx[2][4]; row_rstd(SS, u.pm * BM + wr * 64 + fr, fq, rsx);
#pragma unroll
        for (int ai = 0; ai < 2; ++ai)
#pragma unroll
            for (int m = 0; m < 4; ++m) {
                const int row = u.pm * BM + ai * HALF + wr * 64 + m * 16 + fr;
                f32x4 v[2][2];
#pragma unroll
                for (int bj = 0; bj < 2; ++bj)
#pragma unroll
                    for (int n = 0; n < 2; ++n) v[bj][n] = acc[ai][bj][m][n] * rsx[ai][m];
                if (isqk) {
                    float ss = 0.f;
#pragma unroll
                    for (int bj = 0; bj < 2; ++bj)
#pragma unroll
                        for (int n = 0; n < 2; ++n) ss += (v[bj][n][0] * v[bj][n][0] + v[bj][n][1] * v[bj][n][1]) + (v[bj][n][2] * v[bj][n][2] + v[bj][n][3] * v[bj][n][3]);
                    ss = quad_sum(ss);
                    const float rs = __builtin_amdgcn_rsqf(ss * (1.0f / 64.0f) + 1e-6f);
#pragma unroll
                    for (int bj = 0; bj < 2; ++bj)
#pragma unroll
                        for (int n = 0; n < 2; ++n) v[bj][n] = v[bj][n] * rs * gv[bj][n];
                    if (dorope) {
                        const int pos = (row < 16384) ? row : ((row - 16384) & 4095);
                        const float* cs = rope + (size_t)pos * 16;
#pragma unroll
                        for (int n = 0; n < 2; ++n) {
                            const f32x4 c = *(const f32x4*)(cs + 4 * n), s = *(const f32x4*)(cs + 8 + 4 * n);
                            const f32x4 me = v[0][n]; f32x4 ot;
#pragma unroll
                            for (int i = 0; i < 4; ++i) ot[i] = __shfl_xor(me[i], 16);
                            const f32x4 r0 = me * c - ot * s, r1 = me * c + ot * s;
                            if (fq == 0) v[0][n] = r0; else if (fq == 1) v[0][n] = r1;
                        }
                    }
                    if (isq) {
#pragma unroll
                        for (int bj = 0; bj < 2; ++bj)
#pragma unroll
                            for (int n = 0; n < 2; ++n) v[bj][n] = v[bj][n] * QSCALE_;
                    }
                }
                bf16_t* rowp = dst + (size_t)row * LDQKV_ + pcol;
#pragma unroll
                for (int bj = 0; bj < 2; ++bj) *(u32x4*)(rowp + 32 * bj) = pack8(v[bj][0], v[bj][1]);
            }
    }
};
struct EpiY {
    static constexpr bool PERM = true, AFTER_DRAIN = false, MID = false;
    bf16_t* Y;
    __device__ __forceinline__ void operator()(const f32x4 (&acc)[2][2][4][2], const Unit& u, int wr, int wc, int fr, int fq) const {
        const int row0 = u.pm * BM + wr * 64 + fr, col0 = u.pn * BM + wc * 32 + 8 * fq;
#pragma unroll
        for (int ai = 0; ai < 2; ++ai)
#pragma unroll
            for (int m = 0; m < 4; ++m) {
                bf16_t* rowp = Y + (size_t)(row0 + ai * HALF + m * 16) * LDG_ + col0;
#pragma unroll
                for (int bj = 0; bj < 2; ++bj) *(u32x4*)(rowp + bj * HALF) = pack8(acc[ai][bj][m][0], acc[ai][bj][m][1]);
            }
    }
};
struct EpiGateMerge {
    static constexpr bool PERM = true, AFTER_DRAIN = false, MID = false;
    const bf16_t* Y; bf16_t* MG; const float* SS;
    __device__ __forceinline__ void operator()(const f32x4 (&acc)[2][2][4][2], const Unit& u, int wr, int wc, int fr, int fq) const {
        const int row0 = u.pm * BM + wr * 64 + fr, col0 = u.pn * 128 + wc * 32 + 8 * fq;
        u32x4 ya[4], yb[4];
#pragma unroll
        for (int m = 0; m < 4; ++m) { const bf16_t* yp = Y + (size_t)(row0 + m * 16) * LDG_ + col0; ya[m] = *(const u32x4*)yp; yb[m] = *(const u32x4*)(yp + 1024); }
        float rs[2][4]; row_rstd(SS, row0, fq, rs);
#pragma unroll
        for (int ai = 0; ai < 2; ++ai) {
            if (ai == 1) {
#pragma unroll
                for (int m = 0; m < 4; ++m) { const bf16_t* yp = Y + (size_t)(row0 + HALF + m * 16) * LDG_ + col0; ya[m] = *(const u32x4*)yp; yb[m] = *(const u32x4*)(yp + 1024); }
            }
#pragma unroll
            for (int m = 0; m < 4; ++m) {
                f32x4 v[2];
#pragma unroll
                for (int w = 0; w < 4; ++w) {
                    const int n = w >> 1, i0 = (w & 1) * 2;
                    v[n][i0]     = sigm(acc[ai][0][m][n][i0]     * rs[ai][m]) * bf_lo(ya[m][w]) + sigm(acc[ai][1][m][n][i0]     * rs[ai][m]) * bf_lo(yb[m][w]);
                    v[n][i0 + 1] = sigm(acc[ai][0][m][n][i0 + 1] * rs[ai][m]) * bf_hi(ya[m][w]) + sigm(acc[ai][1][m][n][i0 + 1] * rs[ai][m]) * bf_hi(yb[m][w]);
                }
                *(u32x4*)(MG + (size_t)(row0 + ai * HALF + m * 16) * DM_ + col0) = pack8(v[0], v[1]);
            }
            asm volatile("" ::: "memory");
        }
    }
};
template <class Epi, class Sched, bool ALIGN_EPI = false, bool SP2 = false>
__device__ __forceinline__ void gemm_phase(PG8_LAS unsigned char* lds, const Gemm g, const Sched& S, const Epi& E) {
    int tid_ = threadIdx.x; asm volatile("" : "+v"(tid_));
    const int tid = tid_, wid = __builtin_amdgcn_readfirstlane(tid >> 6), lane = tid & 63, wr = wid >> 2, wc = wid & 3, fr = lane & 15, fq = lane >> 4;
    const int K = g.K, nt = K / BK, lda = g.lda ? g.lda : g.K;
    unsigned voffA[2], voffB[2];
#pragma unroll
    for (int i = 0; i < 2; ++i) { int R, C; stage_rc(tid * 16 + i * 8192, R, C); const int Rb = Epi::PERM ? ((R & ~31) + perm32(R & 31)) : R;
        voffA[i] = (unsigned)(R * lda + C) * 2u; voffB[i] = (unsigned)(Rb * K + C) * 2u; }
    const size_t kstep = (size_t)(BK * 2);
    const size_t hstep = (size_t)HALF * K * 2;
    const size_t tstep = 2 * hstep;
    const size_t hstepA = (size_t)HALF * lda * 2, tstepA = 2 * hstepA;
    const unsigned ldsw = (unsigned)wid * 1024u;
    const int aoff = lds_byte(wr * 64 + fr, fq * 8), boff = lds_byte(wc * 32 + fr, fq * 8);
#define PG8_SA(b, h) (((b) * 2 + (h)) * HTB)
#define PG8_SB(b, h) ((4 + (b) * 2 + (h)) * HTB)
#define PG8_STAGE(bufoff, gbase, voff) do { _Pragma("unroll") for (int _i = 0; _i < 2; ++_i) \
        __builtin_amdgcn_global_load_lds((const unsigned*)((const char*)(gbase) + (voff)[_i]), (PG8_LAS unsigned*)(lds + (bufoff) + ldsw + _i * 8192), 16, 0, 0); } while (0)
#define PG8_LDA(dst, b, h) do { _Pragma("unroll") for (int m = 0; m < 4; ++m) _Pragma("unroll") for (int k = 0; k < 2; ++k) dst[m][k] = *(const PG8_LAS bf16x8*)(lds + PG8_SA(b, h) + aoff + m * 2048 + k * 1024); } while (0)
#define PG8_LDB(dst, b, h) do { _Pragma("unroll") for (int n = 0; n < 2; ++n) _Pragma("unroll") for (int k = 0; k < 2; ++k) dst[n][k] = *(const PG8_LAS bf16x8*)(lds + PG8_SB(b, h) + boff + n * 2048 + k * 1024); } while (0)
#define PG8_MMA(ai, bj, At, Bt) do { __builtin_amdgcn_s_setprio(1); _Pragma("unroll") for (int m = 0; m < 4; ++m) _Pragma("unroll") for (int n = 0; n < 2; ++n) _Pragma("unroll") for (int k = 0; k < 2; ++k) \
        acc[ai][bj][m][n] = __builtin_amdgcn_mfma_f32_16x16x32_bf16(Bt[n][k], At[m][k], acc[ai][bj][m][n], 0, 0, 0); __builtin_amdgcn_s_setprio(0); } while (0)
#define PG8_WAIT_V(n) asm volatile("s_waitcnt vmcnt(" #n ")" ::: "memory")
#define PG8_WAIT_L(n) asm volatile("s_waitcnt lgkmcnt(" #n ")" ::: "memory")
#define PG8_BAR __builtin_amdgcn_s_barrier()
#define PG8_SCHED __builtin_amdgcn_sched_barrier(0)
    Unit cur, nxt; int ui = 0;
    if (!S.next(0, cur)) return;
    f32x4 acc[2][2][4][2];
#pragma unroll
    for (int a = 0; a < 2; ++a)
#pragma unroll
        for (int b = 0; b < 2; ++b)
#pragma unroll
            for (int m = 0; m < 4; ++m)
#pragma unroll
                for (int n = 0; n < 2; ++n) acc[a][b][m][n] = (f32x4){0.f, 0.f, 0.f, 0.f};
    bf16x8 At[4][2], B0[2][2], B1[2][2];
    const char* cA = (const char*)g.A + (size_t)cur.pm * tstepA + (size_t)(cur.pn >> 2) * g.aselb; const char* cB = (const char*)g.Bt + (size_t)cur.pn * tstep;
    S.a_ready(cur);
    if constexpr (SP2) {
        PG8_STAGE(PG8_SB(0, 0), cB, voffB); PG8_STAGE(PG8_SB(0, 1), cB + hstep, voffB); PG8_STAGE(PG8_SA(0, 0), cA, voffA); PG8_STAGE(PG8_SA(0, 1), cA + hstepA, voffA);
        if (wr == 1) PG8_BAR;
        PG8_WAIT_V(2); PG8_BAR;
        PG8_STAGE(PG8_SB(1, 0), cB + kstep, voffB); PG8_STAGE(PG8_SA(1, 0), cA + kstep, voffA); PG8_STAGE(PG8_SB(1, 1), cB + hstep + kstep, voffB);
        PG8_WAIT_V(6); PG8_BAR;
    } else {
        PG8_STAGE(PG8_SB(0, 0), cB, voffB); PG8_STAGE(PG8_SA(0, 0), cA, voffA); PG8_STAGE(PG8_SB(0, 1), cB + hstep, voffB); PG8_STAGE(PG8_SA(0, 1), cA + hstepA, voffA);
        if (wr == 1) PG8_BAR;
        PG8_WAIT_V(4); PG8_BAR;
        PG8_STAGE(PG8_SB(1, 0), cB + kstep, voffB); PG8_STAGE(PG8_SA(1, 0), cA + kstep, voffA); PG8_STAGE(PG8_SB(1, 1), cB + hstep + kstep, voffB);
        PG8_WAIT_V(6); PG8_BAR;
    }
    for (;;) {
        const bool has_next = S.next(ui + 1, nxt);
        const char* nA = has_next ? (const char*)g.A + (size_t)nxt.pm * tstepA + (size_t)(nxt.pn >> 2) * g.aselb : cA; const char* nB = has_next ? (const char*)g.Bt + (size_t)nxt.pn * tstep : cB;
        for (int t = 0; t < nt; t += 2) {
            if constexpr (Epi::MID) { if (t == (nt >> 1)) E.mid(acc, cur, wr, wc, fr, fq); }
            const bool last = (t == nt - 2);
            const char* a1 = cA + (size_t)(t + 1) * kstep;
            const char* a2 = last ? nA : cA + (size_t)(t + 2) * kstep; const char* b2 = last ? nB : cB + (size_t)(t + 2) * kstep;
            const char* a3 = a2 + kstep; const char* b3 = b2 + kstep;
            if (last && has_next) S.a_ready(nxt);
            if constexpr (SP2) {
            PG8_LDB(B0, 0, 0); PG8_LDB(B1, 0, 1); PG8_SCHED; PG8_LDA(At, 0, 0); PG8_STAGE(PG8_SA(1, 1), a1 + hstepA, voffA);
            PG8_WAIT_V(8); PG8_WAIT_L(0); PG8_BAR; PG8_MMA(0, 0, At, B0); PG8_MMA(0, 1, At, B1); PG8_BAR; PG8_SCHED;
            PG8_LDA(At, 0, 1); PG8_STAGE(PG8_SB(0, 0), b2, voffB); PG8_STAGE(PG8_SB(0, 1), b2 + hstep, voffB); PG8_STAGE(PG8_SA(0, 0), a2, voffA);
            PG8_WAIT_V(8); PG8_WAIT_L(0); PG8_BAR; PG8_MMA(1, 0, At, B0); PG8_MMA(1, 1, At, B1); PG8_BAR; PG8_SCHED;
            PG8_LDB(B0, 1, 0); PG8_LDB(B1, 1, 1); PG8_SCHED; PG8_LDA(At, 1, 0); PG8_STAGE(PG8_SA(0, 1), a2 + hstepA, voffA);
            PG8_WAIT_V(8); PG8_WAIT_L(0); PG8_BAR; PG8_MMA(0, 0, At, B0); PG8_MMA(0, 1, At, B1); PG8_BAR; PG8_SCHED;
            PG8_LDA(At, 1, 1); PG8_STAGE(PG8_SB(1, 0), b3, voffB); PG8_STAGE(PG8_SB(1, 1), b3 + hstep, voffB); PG8_STAGE(PG8_SA(1, 0), a3, voffA);
            PG8_WAIT_V(8); PG8_WAIT_L(0); PG8_BAR; PG8_MMA(1, 0, At, B0); PG8_MMA(1, 1, At, B1); PG8_BAR; PG8_SCHED;
            } else {
            PG8_LDB(B0, 0, 0); PG8_SCHED; PG8_LDA(At, 0, 0); PG8_STAGE(PG8_SA(1, 1), a1 + hstepA, voffA);
            PG8_WAIT_L(8); PG8_BAR; PG8_WAIT_L(0); PG8_MMA(0, 0, At, B0); PG8_BAR; PG8_SCHED;
            PG8_LDB(B1, 0, 1); PG8_STAGE(PG8_SB(0, 0), b2, voffB);
            PG8_BAR; PG8_WAIT_L(0); PG8_MMA(0, 1, At, B1); PG8_BAR;
            PG8_LDA(At, 0, 1); PG8_STAGE(PG8_SA(0, 0), a2, voffA);
            PG8_BAR; PG8_WAIT_L(0); PG8_MMA(1, 0, At, B0); PG8_BAR; PG8_SCHED;
            PG8_STAGE(PG8_SB(0, 1), b2 + hstep, voffB);
            PG8_WAIT_V(6); PG8_BAR; PG8_MMA(1, 1, At, B1); PG8_BAR;
            PG8_LDB(B0, 1, 0); PG8_SCHED; PG8_LDA(At, 1, 0); PG8_STAGE(PG8_SA(0, 1), a2 + hstepA, voffA);
            PG8_WAIT_L(8); PG8_BAR; PG8_WAIT_L(0); PG8_MMA(0, 0, At, B0); PG8_BAR; PG8_SCHED;
            PG8_LDB(B1, 1, 1); PG8_STAGE(PG8_SB(1, 0), b3, voffB);
            PG8_BAR; PG8_WAIT_L(0); PG8_MMA(0, 1, At, B1); PG8_BAR;
            PG8_LDA(At, 1, 1); PG8_STAGE(PG8_SA(1, 0), a3, voffA);
            PG8_BAR; PG8_WAIT_L(0); PG8_MMA(1, 0, At, B0); PG8_BAR; PG8_SCHED;
            PG8_STAGE(PG8_SB(1, 1), b3 + hstep, voffB);
            PG8_WAIT_V(6); PG8_BAR; PG8_MMA(1, 1, At, B1); PG8_BAR;
            }
        }
        if constexpr (ALIGN_EPI) { if (wr == 0) PG8_BAR; }
        if constexpr (!Epi::AFTER_DRAIN) { E(acc, cur, wr, wc, fr, fq); S.done(cur); }
        if (!has_next) break;
#pragma unroll
        for (int a = 0; a < 2; ++a)
#pragma unroll
            for (int b = 0; b < 2; ++b)
#pragma unroll
                for (int m = 0; m < 4; ++m)
#pragma unroll
                    for (int n = 0; n < 2; ++n) acc[a][b][m][n] = (f32x4){0.f, 0.f, 0.f, 0.f};
        cur = nxt; cA = nA; cB = nB; ++ui;
        if constexpr (ALIGN_EPI) { if (wr == 1) PG8_BAR; }
    }
    PG8_WAIT_V(0);
    if constexpr (!ALIGN_EPI) { if (wr == 0) PG8_BAR; }
    PG8_BAR;
    if constexpr (Epi::AFTER_DRAIN) { E.fused(acc, cur, wr, wc, fr, fq, lds, wid, lane); S.done(cur); }
#undef PG8_SA
#undef PG8_SB
#undef PG8_STAGE
#undef PG8_LDA
#undef PG8_LDB
#undef PG8_MMA
#undef PG8_WAIT_V
#undef PG8_WAIT_L
#undef PG8_BAR
#undef PG8_SCHED
}
}
namespace att {
#define ALAS __attribute__((address_space(3)))
typedef unsigned short bf16_t;
using bf16x8 = __attribute__((ext_vector_type(8))) short;
using s16x4  = __attribute__((ext_vector_type(4))) short;
using f32x16 = __attribute__((ext_vector_type(16))) float;
using u32x4  = __attribute__((ext_vector_type(4))) unsigned;
constexpr int LD = 1536;
constexpr int SHM_K = 8192, SHM_V = 16384;
constexpr int L_V = 0, L_K = 2 * SHM_V, L_WS = L_K + 2 * SHM_K, L_TAB = L_WS + 2048, L_STASH = L_TAB + 2048, L_END = L_STASH + 65536;
constexpr float THR2 = 8.f;
#define KSWZ(row, colB) ((row) * 128 + ((colB) ^ ((((row) >> 1) & 7) << 4)))
#define SBAR() __builtin_amdgcn_sched_barrier(0)
__device__ __forceinline__ int crow(int r, int hi) { return (r & 3) + 8 * (r >> 2) + 4 * hi; }
typedef float f32x2c_ __attribute__((ext_vector_type(2))); typedef __bf16 bf16x2c_ __attribute__((ext_vector_type(2)));
__device__ __forceinline__ unsigned cvtpk(float lo, float hi) { f32x2c_ v = {lo, hi}; bf16x2c_ b = __builtin_convertvector(v, bf16x2c_); return __builtin_bit_cast(unsigned, b); }

struct NaCtx { int klo, rq, s0q, qc, wstart; const ALAS float* tab; };
__device__ __forceinline__ void na_bias(f32x16& p0, f32x16& p1, int t, int hi, const NaCtx& c) {
  const int kr = c.klo + t; const bool active = (kr >= c.s0q) && (kr <= c.s0q + 7);
  if (!active) {
#pragma unroll
    for (int r = 0; r < 16; ++r) { p0[r] = -1e30f; p1[r] = -1e30f; }
    return;
  }
  const int tb = (kr - c.rq + 7) * 32 + 15 - c.qc;
#pragma unroll
  for (int r = 0; r < 16; ++r) {
    const int kc = crow(r, hi);
    { const bool v = (unsigned)(kc - c.wstart) < 16u; const float b = c.tab[v ? tb + kc : 0]; p0[r] = v ? p0[r] + b : -1e30f; }
    { const int k2 = kc + 32; const bool v = (unsigned)(k2 - c.wstart) < 16u; const float b = c.tab[v ? tb + k2 : 0]; p1[r] = v ? p1[r] + b : -1e30f; }
  }
}
__device__ __forceinline__ void k_issue(bf16x8 (&kf)[8], const ALAS char* Ks, int r32, int hi) {
#pragma unroll
  for (int d0 = 0; d0 < 4; ++d0) { const int cb = (d0 * 16 + hi * 8) * 2;
    kf[2 * d0] = *(const ALAS bf16x8*)(Ks + KSWZ(r32, cb)); kf[2 * d0 + 1] = *(const ALAS bf16x8*)(Ks + KSWZ(32 + r32, cb)); }
}
__device__ __forceinline__ void qkt(f32x16& p0, f32x16& p1, const bf16x8 (&kf)[8], const bf16x8* qr, const f32x16& cinit) {
  p0 = __builtin_amdgcn_mfma_f32_32x32x16_bf16(kf[0], qr[0], cinit, 0, 0, 0); p1 = __builtin_amdgcn_mfma_f32_32x32x16_bf16(kf[1], qr[0], cinit, 0, 0, 0);
#pragma unroll
  for (int d0 = 1; d0 < 4; ++d0) { p0 = __builtin_amdgcn_mfma_f32_32x32x16_bf16(kf[2 * d0], qr[d0], p0, 0, 0, 0); p1 = __builtin_amdgcn_mfma_f32_32x32x16_bf16(kf[2 * d0 + 1], qr[d0], p1, 0, 0, 0); }
}
template <int NC> __device__ __forceinline__ int v_st(int k, int c) { const int kk = (k & ~0xC) | ((k & 4) << 1) | ((k & 8) >> 1); return ((kk >> 3) * NC + (c >> 5)) * 512 + ((kk & 7) * 32 + (c & 31)) * 2; }
__device__ __forceinline__ int v_rd_base(int lane) { return ((lane & 3) << 3) | (((lane >> 2) & 3) << 6) | (((lane >> 4) & 1) << 5) | (((lane >> 5) & 1) << 8); }
template <int NC> constexpr int v_rd_off(int d0, int ks, int half) { return d0 * 512 + (2 * ks + half) * NC * 512; }
template <int OFF> __device__ __forceinline__ s16x4 tr_read(int vb) {
  s16x4 r; asm volatile("ds_read_b64_tr_b16 %0, %1 offset:%2" : "=&v"(r) : "v"(vb), "i"(OFF) : "memory"); return r;
}
template <int NC, int KS> __device__ __forceinline__ void v_issue_k(s16x4 (&L)[8], int vb) {
  L[0] = tr_read<v_rd_off<NC>(0, KS, 0)>(vb); L[1] = tr_read<v_rd_off<NC>(0, KS, 1)>(vb); L[2] = tr_read<v_rd_off<NC>(1, KS, 0)>(vb); L[3] = tr_read<v_rd_off<NC>(1, KS, 1)>(vb);
  if constexpr (NC == 4) { L[4] = tr_read<v_rd_off<NC>(2, KS, 0)>(vb); L[5] = tr_read<v_rd_off<NC>(2, KS, 1)>(vb); L[6] = tr_read<v_rd_off<NC>(3, KS, 0)>(vb); L[7] = tr_read<v_rd_off<NC>(3, KS, 1)>(vb); }
}
template <int NC> __device__ __forceinline__ void v_mma_k(f32x16* o, f32x16& osum, const s16x4 (&L)[8], bf16x8 pa, bf16x8 ones) {
#define PK(A, B) (bf16x8){A[0], A[1], A[2], A[3], B[0], B[1], B[2], B[3]}
  osum = __builtin_amdgcn_mfma_f32_32x32x16_bf16(pa, ones, osum, 0, 0, 0);
  o[0] = __builtin_amdgcn_mfma_f32_32x32x16_bf16(pa, PK(L[0], L[1]), o[0], 0, 0, 0);
  o[1] = __builtin_amdgcn_mfma_f32_32x32x16_bf16(pa, PK(L[2], L[3]), o[1], 0, 0, 0);
  if constexpr (NC == 4) { o[2] = __builtin_amdgcn_mfma_f32_32x32x16_bf16(pa, PK(L[4], L[5]), o[2], 0, 0, 0); o[3] = __builtin_amdgcn_mfma_f32_32x32x16_bf16(pa, PK(L[6], L[7]), o[3], 0, 0, 0); }
#undef PK
}
template <int DV, bool NA>
__device__ __forceinline__ void attn_core(const bf16_t* __restrict__ Qlane, const bf16_t* __restrict__ Kh, const bf16_t* __restrict__ Vh, const int NT,
                                          ALAS char* lds, f32x16 (&o)[DV / 32], const NaCtx& na) {
  constexpr int NC = DV / 32;
  int tid_ = threadIdx.x; asm volatile("" : "+v"(tid_));
  const int tid = tid_, wid = __builtin_amdgcn_readfirstlane(tid >> 6), lane = tid & 63, r32 = lane & 31, hi = lane >> 5;
  ALAS char* V_lds = lds + L_V; ALAS char* K_lds = lds + L_K;
  ALAS float* al_l = (ALAS float*)(lds + L_WS) + wid * 64;
  float m_ref = 0.f;
  f32x16 osum = f32x16{}, negm = f32x16{};
#pragma unroll
  for (int d = 0; d < NC; ++d) o[d] = f32x16{};
  bf16x8 qr[4];
#pragma unroll
  for (int d0 = 0; d0 < 4; ++d0) qr[d0] = *reinterpret_cast<const bf16x8*>(Qlane + d0 * 16);
  const bf16x8 ones = {0x3f80, 0x3f80, 0x3f80, 0x3f80, 0x3f80, 0x3f80, 0x3f80, 0x3f80};
  const int kr_ = tid >> 3, kc8 = (tid & 7) * 8, kst = KSWZ(kr_, kc8 * 2);
  const int vr_ = (DV == 128) ? (tid >> 4) : (tid >> 3), vc8 = (DV == 128) ? (tid & 15) * 8 : (tid & 7) * 8;
  const int vst0 = v_st<NC>(vr_, vc8), vst1 = v_st<NC>((32 + vr_) & 63, vc8);
  const int vb0 = (int)(uintptr_t)V_lds + v_rd_base(lane);
  const int kgo = kr_ * LD + kc8, vgo = vr_ * LD + vc8;
  bf16x8 sk0, sva0, svb0, sk1, sva1, svb1;
#define SLOADX(S, k0) do { sk##S = *reinterpret_cast<const bf16x8*>(Kh + (long)(k0) * LD + kgo); sva##S = *reinterpret_cast<const bf16x8*>(Vh + (long)(k0) * LD + vgo); \
    if constexpr (DV == 128) svb##S = *reinterpret_cast<const bf16x8*>(Vh + (long)((k0) + 32) * LD + vgo); } while (0)
#define SWRITEX(S, b) do { *(ALAS bf16x8*)(V_lds + (b) * SHM_V + vst0) = sva##S; if constexpr (DV == 128) *(ALAS bf16x8*)(V_lds + (b) * SHM_V + vst1) = svb##S; \
    *(ALAS bf16x8*)(K_lds + (b) * SHM_K + kst) = sk##S; } while (0)
#define ACT(t) (!NA || ((na.klo + (t)) >= na.s0q && (na.klo + (t)) <= na.s0q + 7))
  SLOADX(0, 0); asm volatile("s_waitcnt vmcnt(0)" ::: "memory"); SWRITEX(0, 0); SLOADX(1, 64); SLOADX(0, 128); __syncthreads();
  for (int jj = 0; jj < NT; jj += 2) {
#pragma unroll
   for (int par = 0; par < 2; ++par) {
    const int j = jj + par; const int b = par; const bool act = ACT(j);
    bf16x8 kf[8];
    if (act) k_issue(kf, K_lds + b * SHM_K, r32, hi);
    if (par == 0) { if (j + 1 < NT) { SWRITEX(1, 1); if (j + 3 < NT) SLOADX(1, (j + 3) * 64); } }
    else          { if (j + 1 < NT) { SWRITEX(0, 0); if (j + 3 < NT) SLOADX(0, (j + 3) * 64); } }
    if (act) {
      f32x16 p0, p1;
      qkt(p0, p1, kf, qr, negm);
      if constexpr (NA) na_bias(p0, p1, j, hi, na);
      float pmax = fmaxf(p0[0], p1[0]), pmx2 = fmaxf(p0[1], p1[1]);
#pragma unroll
      for (int r = 2; r < 16; r += 2) { pmax = __builtin_fmaxf(__builtin_fmaxf(pmax, p0[r]), p1[r]); pmx2 = __builtin_fmaxf(__builtin_fmaxf(pmx2, p0[r + 1]), p1[r + 1]); }
      pmax = fmaxf(pmax, pmx2);
      { auto rr = __builtin_amdgcn_permlane32_swap(__float_as_uint(pmax), __float_as_uint(pmax), false, false);
        pmax = fmaxf(__uint_as_float(rr[0]), __uint_as_float(rr[1])); }
      if (__builtin_expect(!__all(pmax <= THR2), 0)) {
        const float dl = fmaxf(pmax, 0.f); m_ref += dl;
#pragma unroll
        for (int r = 0; r < 16; ++r) { p0[r] -= dl; p1[r] -= dl; negm[r] = -m_ref; }
        const float f = __builtin_amdgcn_exp2f(-dl);
        if (hi == 0) al_l[r32] = f; asm volatile("s_waitcnt lgkmcnt(0)" ::: "memory");
#pragma unroll
        for (int r = 0; r < 16; ++r) { const float ar = al_l[crow(r, hi)]; osum[r] *= ar;
#pragma unroll
          for (int d = 0; d < NC; ++d) o[d][r] *= ar; }
      }
      const int vb = vb0 + b * SHM_V;
      s16x4 LA[8], LB[8]; bf16x8 pa;
#define PK4(P, BASE, OUT) do { unsigned a0 = cvtpk(P[BASE + 0], P[BASE + 1]), a1 = cvtpk(P[BASE + 2], P[BASE + 3]);   \
    unsigned b0 = cvtpk(P[BASE + 4], P[BASE + 5]), b1 = cvtpk(P[BASE + 6], P[BASE + 7]);                              \
    auto r0 = __builtin_amdgcn_permlane32_swap(a0, b0, false, false); auto r1 = __builtin_amdgcn_permlane32_swap(a1, b1, false, false); \
    u32x4 w = {r0[0], r1[0], r0[1], r1[1]}; OUT = *reinterpret_cast<bf16x8*>(&w); } while (0)
#define EXP8(P, BASE) do { _Pragma("unroll") for (int r = 0; r < 8; ++r) P[BASE + r] = __builtin_amdgcn_exp2f(P[BASE + r]); } while (0)
#define LGKM(n) asm volatile("s_waitcnt lgkmcnt(" #n ")" ::: "memory")
      v_issue_k<NC, 0>(LA, vb);
      EXP8(p0, 0); PK4(p0, 0, pa); SBAR();
      v_issue_k<NC, 1>(LB, vb); if constexpr (NC == 4) LGKM(8); else LGKM(4); SBAR(); v_mma_k<NC>(o, osum, LA, pa, ones); SBAR();
      EXP8(p0, 8); PK4(p0, 8, pa); SBAR();
      v_issue_k<NC, 2>(LA, vb); if constexpr (NC == 4) LGKM(8); else LGKM(4); SBAR(); v_mma_k<NC>(o, osum, LB, pa, ones); SBAR();
      EXP8(p1, 0); PK4(p1, 0, pa); SBAR();
      v_issue_k<NC, 3>(LB, vb); if constexpr (NC == 4) LGKM(8); else LGKM(4); SBAR(); v_mma_k<NC>(o, osum, LA, pa, ones); SBAR();
      EXP8(p1, 8); PK4(p1, 8, pa); SBAR();
      LGKM(0); SBAR(); v_mma_k<NC>(o, osum, LB, pa, ones);
#undef PK4
#undef EXP8
#undef LGKM
    }
    __syncthreads();
   }
  }
#pragma unroll
  for (int r = 0; r < 16; ++r) { const float rl = __builtin_amdgcn_rcpf(osum[r]);
#pragma unroll
    for (int d = 0; d < NC; ++d) o[d][r] *= rl; }
#undef SLOADX
#undef SWRITEX
#undef ACT
}
__device__ __forceinline__ bf16_t to_bf16(float v) { return (bf16_t)(cvtpk(v, 0.f) & 0xffffu); }

constexpr int NAW_V = 0, NAW_TAB = 131072, NAW_TSTRIDE = 2000, NAW_END = NAW_TAB + 8 * NAW_TSTRIDE;
__device__ __forceinline__ void na_wave_units(int gw, int NGW, const bf16_t* QA, bf16_t* AB, const float* rpb  , ALAS char* lds) {
  int tid_ = threadIdx.x; asm volatile("" : "+v"(tid_));
  const int tid = tid_, wid = __builtin_amdgcn_readfirstlane(tid >> 6), lane = tid & 63, r32 = lane & 31, hi = lane >> 5;
  const int h = gw & 7;
  ALAS char* Vw = lds + NAW_V + wid * 16384;
  ALAS float* tab = (ALAS float*)(lds + NAW_TAB + wid * NAW_TSTRIDE);
  for (int i = lane; i < 480; i += 64) { const int dr = i >> 5, dc = i & 31; tab[i] = (dc < 31) ? rpb[(h * 15 + dr) * 31 + dc] * 1.4426950408889634f : 0.f; }
  asm volatile("s_waitcnt lgkmcnt(0)" ::: "memory");
  const bf16x8 ones = {0x3f80, 0x3f80, 0x3f80, 0x3f80, 0x3f80, 0x3f80, 0x3f80, 0x3f80};
  const int vb0 = (int)(uintptr_t)Vw + v_rd_base(lane);
  int vgo[8], vso[8];
#pragma unroll
  for (int i = 0; i < 8; ++i) { const int p = i * 64 + lane, key = p >> 3, c8 = (p & 7) * 8; vgo[i] = key * LD + c8; vso[i] = v_st<2>(key, c8); }
  const int kgo0 = r32 * LD + hi * 8, kgo1 = (32 + r32) * LD + hi * 8;
  for (int wu = gw; wu < 20480; wu += NGW) {
    const int hf = (wu >> 3) & 1, rowg = wu >> 4;
    int base, r, rows;
    if (rowg < 256) { base = 0; r = rowg; rows = 256; } else { const int l = rowg - 256; base = 16384 + (l >> 6) * 4096; r = l & 63; rows = 64; }
    NaCtx c; c.s0q = min(max(r - 4, 0), rows - 8); c.klo = c.s0q; c.rq = r; c.qc = 32 * hf + r32; c.wstart = min(max(c.qc - 8, 0), 48); c.tab = tab;
    const long qrow = (long)base + r * 64 + hf * 32;
    const bf16_t* Qlane = QA + (qrow + r32) * LD + h * 64 + hi * 8;
    const bf16_t* Kb = QA + ((long)base + c.klo * 64) * LD + 512 + h * 64;
    const bf16_t* Vb = QA + ((long)base + c.klo * 64) * LD + 1024 + h * 64;
    bf16x8 qr[4];
#pragma unroll
    for (int d0 = 0; d0 < 4; ++d0) qr[d0] = *reinterpret_cast<const bf16x8*>(Qlane + d0 * 16);
    float m_ref = 0.f; f32x16 osum = f32x16{}, negm = f32x16{}, o[2]; o[0] = f32x16{}; o[1] = f32x16{};
    bf16x8 kf[8], vN[8];
#define KLOAD(t) do { _Pragma("unroll") for (int d0 = 0; d0 < 4; ++d0) { kf[2 * d0] = *reinterpret_cast<const bf16x8*>(Kb + (long)(t) * 64 * LD + kgo0 + d0 * 16); \
                                                                        kf[2 * d0 + 1] = *reinterpret_cast<const bf16x8*>(Kb + (long)(t) * 64 * LD + kgo1 + d0 * 16); } } while (0)
#define VLOAD(t) do { _Pragma("unroll") for (int i = 0; i < 8; ++i) vN[i] = *reinterpret_cast<const bf16x8*>(Vb + (long)(t) * 64 * LD + vgo[i]); } while (0)
#define VWRITE(b) do { _Pragma("unroll") for (int i = 0; i < 8; ++i) *(ALAS bf16x8*)(Vw + (b) * 8192 + vso[i]) = vN[i]; } while (0)
    KLOAD(0); VLOAD(0); VWRITE(0);
#pragma unroll
    for (int t = 0; t < 8; ++t) {
      const int b = t & 1;
      if (t + 1 < 8) VLOAD(t + 1);
      f32x16 p0, p1;
      qkt(p0, p1, kf, qr, negm);
      if (t + 1 < 8) { asm volatile("" ::: "memory"); KLOAD(t + 1); }
      na_bias(p0, p1, t, hi, c);
      float pmax = fmaxf(p0[0], p1[0]), pmx2 = fmaxf(p0[1], p1[1]);
#pragma unroll
      for (int q = 2; q < 16; q += 2) { pmax = __builtin_fmaxf(__builtin_fmaxf(pmax, p0[q]), p1[q]); pmx2 = __builtin_fmaxf(__builtin_fmaxf(pmx2, p0[q + 1]), p1[q + 1]); }
      pmax = fmaxf(pmax, pmx2);
      { auto rr = __builtin_amdgcn_permlane32_swap(__float_as_uint(pmax), __float_as_uint(pmax), false, false); pmax = fmaxf(__uint_as_float(rr[0]), __uint_as_float(rr[1])); }
      if (__builtin_expect(!__all(pmax <= THR2), 0)) {
        const float dl = fmaxf(pmax, 0.f); m_ref += dl;
#pragma unroll
        for (int q = 0; q < 16; ++q) { p0[q] -= dl; p1[q] -= dl; negm[q] = -m_ref; }
        const float f = __builtin_amdgcn_exp2f(-dl);
#pragma unroll
        for (int q = 0; q < 16; ++q) { const float ar = __shfl(f, crow(q, hi), 64); osum[q] *= ar; o[0][q] *= ar; o[1][q] *= ar; }
      }
#pragma unroll
      for (int q = 0; q < 16; ++q) { p0[q] = __builtin_amdgcn_exp2f(p0[q]); p1[q] = __builtin_amdgcn_exp2f(p1[q]); }
      bf16x8 pa0, pa1, pa2, pa3;
#define PK4(P, BASE, OUT) do { unsigned a0 = cvtpk(P[BASE + 0], P[BASE + 1]), a1 = cvtpk(P[BASE + 2], P[BASE + 3]);   \
    unsigned b0 = cvtpk(P[BASE + 4], P[BASE + 5]), b1 = cvtpk(P[BASE + 6], P[BASE + 7]);                              \
    auto r0 = __builtin_amdgcn_permlane32_swap(a0, b0, false, false); auto r1 = __builtin_amdgcn_permlane32_swap(a1, b1, false, false); \
    u32x4 w = {r0[0], r1[0], r0[1], r1[1]}; OUT = *reinterpret_cast<bf16x8*>(&w); } while (0)
      PK4(p0, 0, pa0); PK4(p0, 8, pa1); PK4(p1, 0, pa2); PK4(p1, 8, pa3);
#undef PK4
      { const int vb = vb0 + b * 8192; s16x4 LA[8], LB[8];
        v_issue_k<2, 0>(LA, vb); v_issue_k<2, 1>(LB, vb); asm volatile("s_waitcnt lgkmcnt(4)" ::: "memory"); SBAR(); v_mma_k<2>(o, osum, LA, pa0, ones); SBAR();
        v_issue_k<2, 2>(LA, vb); asm volatile("s_waitcnt lgkmcnt(4)" ::: "memory"); SBAR(); v_mma_k<2>(o, osum, LB, pa1, ones); SBAR();
        v_issue_k<2, 3>(LB, vb); asm volatile("s_waitcnt lgkmcnt(4)" ::: "memory"); SBAR(); v_mma_k<2>(o, osum, LA, pa2, ones); SBAR();
        asm volatile("s_waitcnt lgkmcnt(0)" ::: "memory"); SBAR(); v_mma_k<2>(o, osum, LB, pa3, ones); }
      if (t + 1 < 8) VWRITE(b ^ 1);
    }
#undef KLOAD
#undef VLOAD
#undef VWRITE
    bf16_t* Ow = AB + qrow * 1024 + h * 64 + r32;
#pragma unroll
    for (int q = 0; q < 16; ++q) { const float rl = __builtin_amdgcn_rcpf(osum[q]); const int orow = crow(q, hi);
      Ow[(long)orow * 1024] = to_bf16(o[0][q] * rl); Ow[(long)orow * 1024 + 32] = to_bf16(o[1][q] * rl); }
    asm volatile("s_waitcnt lgkmcnt(0)" ::: "memory");
  }
}
__device__ __forceinline__ void diff_unit(int base, int seq, int h, int qblk, const bf16_t* QB, bf16_t* AB, float lam, float one_m_li, const float* subln, ALAS char* lds) {
  int tid_ = threadIdx.x; asm volatile("" : "+v"(tid_));
  const int tid = tid_, wid = __builtin_amdgcn_readfirstlane(tid >> 6), lane = tid & 63, r32 = lane & 31, hi = lane >> 5;
  const int row0 = base + qblk * 256;
  ALAS unsigned* stash = (ALAS unsigned*)(lds + L_STASH) + wid * 2048;
  NaCtx c{};
  f32x16 o[4];
  for (int mp = 0; mp < 2; ++mp) {
    const bf16_t* Qlane = QB + (long)(row0 + wid * 32 + r32) * LD + h * 128 + mp * 64 + hi * 8;
    const bf16_t* Kh = QB + (long)base * LD + 512 + h * 128 + mp * 64;
    const bf16_t* Vh = QB + (long)base * LD + 1024 + h * 128;
    attn_core<128, false>(Qlane, Kh, Vh, seq >> 6, lds, o, c);
    if (mp == 0) {
#pragma unroll
      for (int d0 = 0; d0 < 4; ++d0)
#pragma unroll
        for (int r = 0; r < 16; r += 2) stash[(d0 * 8 + (r >> 1)) * 64 + lane] = cvtpk(o[d0][r], o[d0][r + 1]);
    }
  }
  asm volatile("s_waitcnt lgkmcnt(0)" ::: "memory");
  float sg[4];
#pragma unroll
  for (int d0 = 0; d0 < 4; ++d0) sg[d0] = subln[d0 * 32 + r32] * one_m_li;
  bf16_t* Ow = AB + (long)(row0 + wid * 32) * 1024 + 512 + h * 128 + r32;
#pragma unroll
  for (int r = 0; r < 16; r += 2) {
    float v0[4], v1[4]; float s0 = 0.f, s1 = 0.f;
#pragma unroll
    for (int d0 = 0; d0 < 4; ++d0) { const unsigned w = stash[(d0 * 8 + (r >> 1)) * 64 + lane];
      v0[d0] = __uint_as_float(w << 16) - lam * o[d0][r]; v1[d0] = __uint_as_float(w & 0xffff0000u) - lam * o[d0][r + 1];
      s0 += v0[d0] * v0[d0]; s1 += v1[d0] * v1[d0]; }
#pragma unroll
    for (int x = 1; x < 32; x <<= 1) { s0 += __shfl_xor(s0, x); s1 += __shfl_xor(s1, x); }
    const float rs0 = __builtin_amdgcn_rsqf(s0 * (1.0f / 128.0f) + 1e-5f), rs1 = __builtin_amdgcn_rsqf(s1 * (1.0f / 128.0f) + 1e-5f);
    const int or0 = crow(r, hi), or1 = crow(r + 1, hi);
#pragma unroll
    for (int d0 = 0; d0 < 4; ++d0) { Ow[(long)or0 * 1024 + d0 * 32] = to_bf16(v0[d0] * rs0 * sg[d0]); Ow[(long)or1 * 1024 + d0 * 32] = to_bf16(v1[d0] * rs1 * sg[d0]); }
  }
}
#undef SBAR
}
#define LAS __attribute__((address_space(3)))
typedef unsigned short bf16;
typedef unsigned v4u __attribute__((ext_vector_type(4)));
typedef unsigned v2u __attribute__((ext_vector_type(2)));
typedef float f32x4 __attribute__((ext_vector_type(4)));
constexpr int NWAVES = 8;
constexpr int MTOK = 81920, NP = 16384, DM = 1024, DFF = 2816, NLAYER = 2;
constexpr size_t MiB = 1u << 20;
constexpr size_t WS_GNH = 64 * 1024;
constexpr size_t WS_RPB = 128 * 1024, WS_SUB = 192 * 1024, WS_LAM = 200 * 1024;
constexpr size_t WS_ROPE = 1 * MiB;
constexpr size_t WS_W = 4 * MiB, WS_WL = 48 * MiB;
constexpr size_t WS_H = 104 * MiB;
constexpr size_t WS_R = 264 * MiB;
constexpr size_t WS_T = WS_R;
constexpr size_t WS_QA = WS_R, WS_QB = WS_R + 240 * MiB, WS_AB = WS_R + 480 * MiB;
constexpr size_t WS_G = WS_R, WS_MG = WS_R + 320 * MiB;
constexpr size_t WS_SS = WS_R + 640 * MiB;
constexpr size_t WS_END = WS_SS + 6 * MiB;
constexpr size_t WO_WI1 = 0, WO_WO1 = WO_WI1 + (size_t)5632 * 1024, WO_QKV = WO_WO1 + (size_t)1024 * 2816, WO_G = WO_QKV + (size_t)3072 * 1024,
                 WO_AB = WO_G + (size_t)2048 * 1024, WO_OUT = WO_AB + (size_t)1024 * 1024, WO_WI2 = WO_OUT + (size_t)1024 * 1024, WO_WO2 = WO_WI2 + (size_t)5632 * 1024,
                 WO_END = WO_WO2 + (size_t)1024 * 2816;
static_assert(WO_END * 2 <= WS_WL, "weight block");
constexpr int RING_BYTES = 131072, LDS_BYTES = 147456;
static_assert(att::L_END <= LDS_BYTES && att::NAW_END <= LDS_BYTES - 64, "attention LDS");

#define LDS_WAIT() asm volatile("s_waitcnt lgkmcnt(0)" ::: "memory")
__device__ __forceinline__ unsigned f2bf(float f) { unsigned u = __builtin_bit_cast(unsigned, f); return (u + 0x7fffu + ((u >> 16) & 1u)) >> 16; }
__device__ __forceinline__ unsigned pk2(float lo, float hi) { return pg8::cvt_pk_bf16(lo, hi); }
__device__ __forceinline__ float wave_sum(float v) {
#pragma unroll
    for (int o = 1; o < 64; o <<= 1) v += __shfl_xor(v, o);
    return v;
}
__device__ __forceinline__ void tr_item(const float* W, int N, int k0, int n0, bf16* dst, int drow0, int ldd, int koff, LAS float* scr, int lane, const float* g = nullptr) {
    {   const int kr = lane >> 3, c4 = (lane & 7) * 4;
        f32x4 wv[8];
#pragma unroll
        for (int i = 0; i < 8; ++i) wv[i] = *(const f32x4*)(W + (size_t)(k0 + i * 8 + kr) * N + n0 + c4);
#pragma unroll
        for (int i = 0; i < 8; ++i) { const int kk = i * 8 + kr; const float gk = g ? g[k0 + kk] : 1.0f; LAS float* d = scr + kk * 33 + c4;
            d[0] = wv[i][0] * gk; d[1] = wv[i][1] * gk; d[2] = wv[i][2] * gk; d[3] = wv[i][3] * gk; } }
    LDS_WAIT(); asm volatile("" ::: "memory");
    const int c = lane & 7;
#pragma unroll
    for (int j = 0; j < 4; ++j) { const int n = (lane >> 3) + 8 * j; const LAS float* s = scr + (8 * c) * 33 + n;
        v4u o; o.x = pk2(s[0 * 33], s[1 * 33]); o.y = pk2(s[2 * 33], s[3 * 33]); o.z = pk2(s[4 * 33], s[5 * 33]); o.w = pk2(s[6 * 33], s[7 * 33]);
        *(v4u*)(dst + (size_t)(drow0 + n) * ldd + koff + k0 + 8 * c) = o; }
    LDS_WAIT(); asm volatile("" ::: "memory");
}
__device__ __forceinline__ void xb_row2(const float* xa, const float* xb_, bf16* oa, bf16* ob, float* sa, float* sb, int lane) {
    const f32x4* ra = (const f32x4*)xa + lane; const f32x4* rb = (const f32x4*)xb_ + lane;
    f32x4 va[4], vb[4]; float s0 = 0.f, s1 = 0.f;
#pragma unroll
    for (int j = 0; j < 4; ++j) { va[j] = ra[64 * j]; vb[j] = rb[64 * j]; }
#pragma unroll
    for (int j = 0; j < 4; ++j) { s0 += (va[j].x * va[j].x + va[j].y * va[j].y) + (va[j].z * va[j].z + va[j].w * va[j].w); s1 += (vb[j].x * vb[j].x + vb[j].y * vb[j].y) + (vb[j].z * vb[j].z + vb[j].w * vb[j].w); }
#pragma unroll
    for (int o = 1; o < 64; o <<= 1) { s0 += __shfl_xor(s0, o); s1 += __shfl_xor(s1, o); }
    v2u* pa = (v2u*)oa + lane; v2u* pb = (v2u*)ob + lane;
#pragma unroll
    for (int j = 0; j < 4; ++j) { v2u w; w.x = pk2(va[j].x, va[j].y); w.y = pk2(va[j].z, va[j].w); pa[64 * j] = w; v2u z; z.x = pk2(vb[j].x, vb[j].y); z.y = pk2(vb[j].z, vb[j].w); pb[64 * j] = z; }
    if (lane < 16) { sa[lane] = (lane == 0) ? s0 : 0.f; sb[lane] = (lane == 0) ? s1 : 0.f; }
}
__device__ __forceinline__ void xb_row(const float* xrow, bf16* orow, float* ssrow, int lane) {
    const f32x4* xr = (const f32x4*)xrow + lane;
    f32x4 v[4]; float s = 0.f;
#pragma unroll
    for (int j = 0; j < 4; ++j) { v[j] = xr[64 * j]; s += (v[j].x * v[j].x + v[j].y * v[j].y) + (v[j].z * v[j].z + v[j].w * v[j].w); }
    s = wave_sum(s);
    v2u* o8 = (v2u*)orow + lane;
#pragma unroll
    for (int j = 0; j < 4; ++j) { v2u w; w.x = pk2(v[j].x, v[j].y); w.y = pk2(v[j].z, v[j].w); o8[64 * j] = w; }
    if (lane < 16) ssrow[lane] = (lane == 0) ? s : 0.f;
}

constexpr size_t WS_BAR = 256 * 1024;
#define RLX_AGENT __ATOMIC_RELAXED, __HIP_MEMORY_SCOPE_AGENT
#define XB_TMO      128
#define XB_XCNT(j)  (256  + 64 * (j))
#define XB_XSUB(j)  (1280 + 64 * (j))
#define XB_XGEN(j)  (2304 + 64 * (j))
#define XB_TOP      3328
#define XB_TOPGEN   3392
#define XCD_BAR_WORDS 3456
#define XB_SPIN_CAP (1u << 18)

__device__ __forceinline__ unsigned xb_ld(unsigned* p)              { return __hip_atomic_load(p, __ATOMIC_RELAXED, __HIP_MEMORY_SCOPE_AGENT); }
__device__ __forceinline__ unsigned xb_add(unsigned* p, unsigned v) { return __hip_atomic_fetch_add(p, v, __ATOMIC_RELAXED, __HIP_MEMORY_SCOPE_AGENT); }
__device__ __forceinline__ unsigned xb_xcc_id() { return (unsigned)__builtin_amdgcn_s_getreg((3 << 11) | 20) & 0xFu; }
#define XB_SPIN(cond, bar) do { unsigned _sp = 0; while (cond) { __builtin_amdgcn_s_sleep(1); \
    if ((++_sp & 255u) == 0u) { if (xb_ld(&(bar)[XB_TMO])) break; if (_sp > XB_SPIN_CAP) { atomicAdd(&(bar)[XB_TMO], 1u); break; } } } } while (0)

struct XcdBarrier {
    unsigned* bar; unsigned x;
    volatile LAS unsigned* st;
};

__device__ __forceinline__ XcdBarrier xcd_barrier_post(unsigned* bar, volatile LAS unsigned* st) {
    XcdBarrier b; b.bar = bar; b.x = xb_xcc_id(); b.st = st;
    if (threadIdx.x == 0) (void)xb_add(&bar[XB_XCNT(b.x)], 1u);
    return b;
}
__device__ __forceinline__ void xcd_barrier_complete(unsigned* bar, unsigned x, unsigned& nloc, unsigned& nx) {
    const unsigned G = gridDim.x * gridDim.y * gridDim.z;
    unsigned sum, cnt, mine, sp = 0u;
    for (;;) {
        sum = 0u; cnt = 0u; mine = 0u;
#pragma unroll
        for (unsigned j = 0; j < 16; ++j) { const unsigned c = xb_ld(&bar[XB_XCNT(j)]); sum += c; cnt += (c > 0u) ? 1u : 0u; mine = (j == x) ? c : mine; }
        if (sum == G) break;
        __builtin_amdgcn_s_sleep(1);
        if ((++sp & 255u) == 0u) { if (xb_ld(&bar[XB_TMO])) break; if (sp > XB_SPIN_CAP) { atomicAdd(&bar[XB_TMO], 1u); break; } }
    }
    nloc = mine > 0u ? mine : 1u; nx = cnt > 0u ? cnt : 1u;
}

__device__ __forceinline__ void xcd_barrier(const XcdBarrier& b) {
    asm volatile("s_waitcnt vmcnt(0)" ::: "memory");
    __syncthreads();
    if (threadIdx.x == 0) {
        unsigned* bar = b.bar;
        __builtin_amdgcn_s_waitcnt(0);
        unsigned nloc = b.st[0], nx = b.st[1];
        if (nloc == 0u) { xcd_barrier_complete(bar, b.x, nloc, nx); b.st[0] = nloc; b.st[1] = nx; }
        const unsigned old = xb_add(&bar[XB_XSUB(b.x)], 1u);
        const unsigned gen = old / nloc;
        if (old + 1u == (gen + 1u) * nloc) {
            __builtin_amdgcn_fence(__ATOMIC_RELEASE, "agent");
            asm volatile("s_waitcnt vmcnt(0)" ::: "memory");
            const unsigned og = xb_add(&bar[XB_TOP], 1u);
            const unsigned tg = og / nx;
            if (og + 1u == (tg + 1u) * nx) xb_add(&bar[XB_TOPGEN], 1u);
            else XB_SPIN(xb_ld(&bar[XB_TOPGEN]) == tg, bar);
            __builtin_amdgcn_fence(__ATOMIC_ACQUIRE, "agent");
            xb_add(&bar[XB_XGEN(b.x)], 1u);
            asm volatile("s_waitcnt vmcnt(0)" ::: "memory");
        } else {
            XB_SPIN(xb_ld(&bar[XB_XGEN(b.x)]) == gen, bar);
            __builtin_amdgcn_fence(__ATOMIC_ACQUIRE, "agent");
            asm volatile("s_waitcnt vmcnt(0)" ::: "memory");
        }
    }
    __syncthreads();
}

#define GSYNC() xcd_barrier(xbar)
struct Args { const float* in[23]; float* out; unsigned char* ws; };

__global__ void __launch_bounds__(NWAVES * 64, 2) mega_fwd(Args a) {
    extern __shared__ __attribute__((aligned(16))) unsigned char lds_raw[];
    cg::grid_group grid = cg::this_grid();
    LAS unsigned char* lds = (LAS unsigned char*)lds_raw;
    const int tid = threadIdx.x, lane = tid & 63, wave = __builtin_amdgcn_readfirstlane(tid >> 6);
    const int G = gridDim.x, bx = blockIdx.x;
    const int vcu = (G % 8 == 0) ? (bx % 8) * (G / 8) + bx / 8 : bx;
    const int gw = vcu * NWAVES + wave, NGW = G * NWAVES;
    unsigned char* ws = a.ws;
    volatile LAS unsigned* xb_st = (volatile LAS unsigned*)(lds + LDS_BYTES - 64);
    if (tid < 2) xb_st[tid] = 0u;
    __syncthreads();
    const XcdBarrier xbar = xcd_barrier_post((unsigned*)(ws + WS_BAR), xb_st);
    float* xbuf = a.out;
    bf16* Hb = (bf16*)(ws + WS_H); bf16* Tb = (bf16*)(ws + WS_T); bf16* QAb = (bf16*)(ws + WS_QA); bf16* QBb = (bf16*)(ws + WS_QB);
    bf16* ABb = (bf16*)(ws + WS_AB); bf16* Gb = (bf16*)(ws + WS_G); bf16* MGb = (bf16*)(ws + WS_MG); float* rope = (float*)(ws + WS_ROPE); float* SSb = (float*)(ws + WS_SS); float* gnh = (float*)(ws + WS_GNH); float* rpbw = (float*)(ws + WS_RPB); float* subw = (float*)(ws + WS_SUB); float* lamw = (float*)(ws + WS_LAM);

    {
        LAS float* scr = (LAS float*)(lds + wave * 16384);
        constexpr int I0 = 16 * 176, I1 = 44 * 32, I2 = 16 * 160, I3 = 8 * 32, I4 = 8 * 32, I5 = 16 * 32, I6 = I0, I7 = I1;
        constexpr int NI = I0 + I1 + I2 + I3 + I4 + I5 + I6 + I7;
        for (int it = gw; it < NLAYER * NI; it += NGW) {
            const int l = it / NI; int r = it % NI;
            bf16* wl = (bf16*)(ws + WS_W + (size_t)l * WS_WL);
            if (r < I0 || (r >= I0 + I1 + I2 + I3 + I4 + I5 && r < NI - I7)) {
                const bool second = r >= I0; if (second) r -= I0 + I1 + I2 + I3 + I4 + I5;
                const float* W = a.in[second ? 21 : 3] + (size_t)l * 1024 * 5632;
                const int kb = r / 176, nb = r % 176, n0 = nb * 32; const int bj = n0 >= 2816, j = n0 - bj * 2816;
                tr_item(W, 5632, kb * 64, n0, wl + (second ? WO_WI2 : WO_WI1), 256 * (j >> 7) + 128 * bj + (j & 127), 1024, 0, scr, lane, a.in[second ? 20 : 2] + (size_t)l * DM);
                continue;
            }
            if (r >= NI - I7) { r -= NI - I7; const float* W = a.in[22] + (size_t)l * 2816 * 1024; const int kb = r / 32, nb = r % 32;
                tr_item(W, 1024, kb * 64, nb * 32, wl + WO_WO2, nb * 32, 2816, 0, scr, lane); continue; }
            r -= I0;
            if (r < I1) { const float* W = a.in[4] + (size_t)l * 2816 * 1024; const int kb = r / 32, nb = r % 32;
                tr_item(W, 1024, kb * 64, nb * 32, wl + WO_WO1, nb * 32, 2816, 0, scr, lane); continue; }
            r -= I1;
            if (r < I2) { const float* W = a.in[6] + (size_t)l * 1024 * 5120; const int kb = r / 160, nb = r % 160, n0 = nb * 32;
                if (n0 < 3072) { const int blk = n0 >> 8, o = n0 & 255, hh = o >> 6, bb = (o & 63) >> 5;
                    tr_item(W, 5120, kb * 64, n0, wl + WO_QKV, blk * 256 + 128 * bb + 32 * hh, 1024, 0, scr, lane, a.in[5] + (size_t)l * DM); }
                else { const int np = n0 - 3072, pb = np >= 1024, j = np - pb * 1024;
                    tr_item(W, 5120, kb * 64, n0, wl + WO_G, 256 * (j >> 7) + 128 * pb + (j & 127), 1024, 0, scr, lane, a.in[5] + (size_t)l * DM); }
                continue; }
            r -= I2;
            if (r < I3) { const float* W = a.in[17] + (size_t)l * 512 * 1024; const int kb = r / 32, nb = r % 32;
                tr_item(W, 1024, kb * 64, nb * 32, wl + WO_AB, nb * 32, 512, 0, scr, lane); continue; }
            r -= I3;
            if (r < I4) { const float* W = a.in[18] + (size_t)l * 512 * 1024; const int kb = r / 32, nb = r % 32;
                tr_item(W, 1024, kb * 64, nb * 32, wl + WO_AB, 1024 + nb * 32, 512, 0, scr, lane); continue; }
            r -= I4;
            { const float* W = a.in[19] + (size_t)l * 1024 * 1024; const int kb = r / 32, nb = r % 32;
                tr_item(W, 1024, kb * 64, nb * 32, wl + WO_OUT, nb * 32, 1024, 0, scr, lane); }
        }
        for (int mrow = gw; mrow < MTOK; mrow += 2 * NGW) {
            const int m2 = mrow + NGW;
            const float* xa = mrow < NP ? a.in[0] + (size_t)mrow * DM : a.in[1] + (size_t)(mrow - NP) * DM;
            if (m2 < MTOK) { const float* xb2 = m2 < NP ? a.in[0] + (size_t)m2 * DM : a.in[1] + (size_t)(m2 - NP) * DM;
                xb_row2(xa, xb2, Hb + (size_t)mrow * DM, Hb + (size_t)m2 * DM, SSb + (size_t)mrow * 16, SSb + (size_t)m2 * 16, lane); }
            else xb_row(xa, Hb + (size_t)mrow * DM, SSb + (size_t)mrow * 16, lane);
        }
        for (int idx = (vcu * NWAVES * 64 + tid); idx < NLAYER * 6 * 64; idx += G * NWAVES * 64) {
            const int l = idx / 384, p = (idx / 64) % 6, c = idx % 64;
            gnh[idx] = (p == 0) ? a.in[7][l * 64 + c] : (p == 1) ? a.in[8][l * 64 + c] : (p == 3) ? a.in[10][l * 64 + c] : (p == 4) ? a.in[11][l * 64 + c] : 1.0f;
        }
        for (int idx = (vcu * NWAVES * 64 + tid); idx < NLAYER * 3720; idx += G * NWAVES * 64) rpbw[idx] = a.in[9][idx];
        for (int idx = (vcu * NWAVES * 64 + tid); idx < NLAYER * 128; idx += G * NWAVES * 64) subw[idx] = a.in[16][idx];
        if (vcu == 0 && wave < NLAYER) { const int l = wave;
            const float s1 = wave_sum(a.in[12][l * 64 + lane] * a.in[13][l * 64 + lane]), s2 = wave_sum(a.in[14][l * 64 + lane] * a.in[15][l * 64 + lane]);
            if (lane == 0) lamw[l] = expf(s1) - expf(s2) + (0.8f - 0.6f * expf(-0.3f * (float)l)); }
        for (int idx = (vcu * NWAVES * 64 + tid); idx < NP * 8; idx += G * NWAVES * 64) {
            const int pos = idx >> 3, i = idx & 7;
            const float invf = (i == 0) ? 1.0f : (i == 1) ? 0.19392274474868576f : (i == 2) ? 0.03760603093086393f : (i == 3) ? 0.007292664737217109f :
                               (i == 4) ? 0.001414213562373095f : (i == 5) ? 0.0002742481756762073f : (i == 6) ? 5.318295896944988e-05f : 1.031338537721246e-05f;
            const float angf = (float)pos * invf;
            const double ang = (double)angf; const double k = __builtin_rint(ang * 0.15915494309189535); const double r = __builtin_fma(-k, 6.283185307179586, ang) - k * 2.4492935982947064e-16;
            const double x2 = r * r; double ts = 1.0, tc = 1.0, ss = 1.0, sc = 1.0;
#pragma unroll
            for (int q = 1; q <= 14; ++q) { tc = -tc * x2 * (1.0 / (double)((2 * q - 1) * (2 * q))); ts = -ts * x2 * (1.0 / (double)((2 * q) * (2 * q + 1))); sc += tc; ss += ts; }
            rope[pos * 16 + i] = (float)sc; rope[pos * 16 + 8 + i] = (float)(ss * r);
        }
    }
    GSYNC();
    grid.sync();

    float lam = 0.f, one_m_li = 1.f;
    for (int ph = 0; ph < NLAYER * 9; ++ph) {
        const int l = ph / 9, k = ph % 9;
        const bf16* wl = (const bf16*)(ws + WS_W + (size_t)l * WS_WL);
        const bool first_x = (ph == 1);
        if (k == 0 || k == 7) {
            pg8::Gemm g{Hb, wl + (k == 0 ? WO_WI1 : WO_WI2), MTOK, 5632, 1024}; pg8::StaticOrder S; S.init(MTOK, 5632, G, bx, ph & 1);
            pg8::EpiSwiglu E{Tb, SSb};
            pg8::gemm_phase<pg8::EpiSwiglu, pg8::StaticOrder, true, true>(lds, g, S, E);
        } else if (k == 1 || k == 6 || k == 8) {
            pg8::Gemm g{k == 6 ? MGb : Tb, wl + (k == 1 ? WO_WO1 : k == 6 ? WO_OUT : WO_WO2), MTOK, 1024, k == 6 ? 1024 : 2816}; pg8::StaticOrder S; S.init(MTOK, 1024, G, bx, ph & 1);
            pg8::EpiResid E{xbuf, k == 6 ? 1.0f : 0.5f, Hb, SSb, (ph == NLAYER * 9 - 1) ? 1 : 0};
            pg8::gemm_phase<pg8::EpiResid, pg8::StaticOrder, true, true>(lds, g, S, E);
        } else if (k == 2) {
            pg8::Gemm g{Hb, wl + WO_QKV, MTOK, 3072, 1024}; pg8::StaticOrder S; S.init(MTOK, 3072, G, bx, ph & 1);
            pg8::EpiQKV E{QAb, QBb, gnh + l * 384, rope, SSb};
            pg8::gemm_phase<pg8::EpiQKV, pg8::StaticOrder, true, true>(lds, g, S, E);
        } else if (k == 3) {
            const float li = 0.8f - 0.6f * expf(-0.3f * (float)l);
            lam = lamw[l]; one_m_li = 1.0f - li;
            const float* subln = subw + l * 128;
            for (int u = vcu; u < 256 + 1024; u += G) {
                if (u < 256) att::diff_unit(0, NP, u >> 6, u & 63, QBb, ABb, lam, one_m_li, subln, (LAS char*)lds);
                else { const int v = u - 256; att::diff_unit(NP + (v >> 6) * 4096, 4096, (v >> 4) & 3, v & 15, QBb, ABb, lam, one_m_li, subln, (LAS char*)lds); }
            }
            const float* rpb = rpbw + (size_t)l * 8 * 15 * 31;
            __syncthreads();
            att::na_wave_units(gw, NGW, QAb, ABb, rpb, (LAS char*)lds);
        } else if (k == 4) {
            pg8::Gemm g{ABb, wl + WO_AB, MTOK, 2048, 512, 1024, 1024}; pg8::StaticOrder S; S.init(MTOK, 2048, G, bx, ph & 1);
            pg8::EpiY E{Gb};
            pg8::gemm_phase<pg8::EpiY, pg8::StaticOrder, false, true>(lds, g, S, E);
        } else {
            pg8::Gemm g{Hb, wl + WO_G, MTOK, 2048, 1024}; pg8::StaticOrder S; S.init(MTOK, 2048, G, bx, ph & 1);
            pg8::EpiGateMerge E{Gb, MGb, SSb};
            pg8::gemm_phase<pg8::EpiGateMerge, pg8::StaticOrder, true, true>(lds, g, S, E);
        }
        if (ph != NLAYER * 9 - 1) GSYNC();
    }
}

extern "C" void kernel_launch(void* const* d_in, const int* in_sizes, int n_in, void* d_out, int out_size, void* d_ws, size_t ws_size, hipStream_t stream) {
    static int grid = 0;
    if (grid == 0) {
        if (n_in != 23 || out_size != MTOK * DM || ws_size < WS_END) { fprintf(stderr, "kernel_launch: unexpected shapes: n_in %d out %d ws %zu (need >= %zu)\n", n_in, out_size, ws_size, (size_t)WS_END); grid = -1; return; }
        int dev = 0, cus = 0, per_cu = 0;
        (void)hipGetDevice(&dev); (void)hipDeviceGetAttribute(&cus, hipDeviceAttributeMultiprocessorCount, dev);
        if (hipFuncSetAttribute((const void*)mega_fwd, hipFuncAttributeMaxDynamicSharedMemorySize, LDS_BYTES) != hipSuccess) { fprintf(stderr, "kernel_launch: hipFuncSetAttribute failed\n"); grid = -1; return; }
        if (hipOccupancyMaxActiveBlocksPerMultiprocessor(&per_cu, (const void*)mega_fwd, NWAVES * 64, LDS_BYTES) != hipSuccess || per_cu < 1) { fprintf(stderr, "kernel_launch: occupancy query says %d\n", per_cu); per_cu = 1; }
        (void)hipGetLastError();
        grid = cus * per_cu;
        fprintf(stderr, "kernel_launch: grid %d (cus %d x %d)\n", grid, cus, per_cu);
    }
    if (grid < 0) return;
    if (hipMemsetAsync((char*)d_ws + WS_BAR, 0, 16384, stream) != hipSuccess) { fprintf(stderr, "kernel_launch: memset failed\n"); return; }
    Args a{};
    for (int i = 0; i < 23; ++i) a.in[i] = (const float*)d_in[i];
    a.out = (float*)d_out; a.ws = (unsigned char*)d_ws;
    void* args[] = {&a};
    const hipError_t e = hipLaunchCooperativeKernel((const void*)mega_fwd, dim3(grid), dim3(NWAVES * 64), args, LDS_BYTES, stream);
    if (e != hipSuccess) fprintf(stderr, "kernel_launch: cooperative launch failed: %s (grid %d)\n", hipGetErrorString(e), grid);
}
```
